# Optimizing an MI355X kernel written in HIP

```python
import math
import jax, jax.numpy as jnp
from jax import lax
import numpy as np


D_MODEL = 1024
BATCH = 8
SEQ = 4096
DEPTH = 1

GRID_W = 64
CTX_LEN = 256
MIX_WIDTH = D_MODEL
HEAD_DIM = 64
ATTN_WIDTH = MIX_WIDTH // 2
N_Q_HEADS = ATTN_WIDTH // HEAD_DIM
N_KV_HEADS = max(1, N_Q_HEADS // 4)
GROUP = N_Q_HEADS // N_KV_HEADS
KV_WIDTH = N_KV_HEADS * HEAD_DIM
HYENA_WIDTH = MIX_WIDTH - ATTN_WIDTH
IN_WIDTH = ATTN_WIDTH + 2 * KV_WIDTH + 3 * HYENA_WIDTH
WINDOW = 128
ATTN_BLOCK = 128
ATTN_SCALE = HEAD_DIM ** -0.5
ROPE_BASE = 10000.0
SHORT_CONV = 3
POS_EMB_DIM = 33
POS_BANDS = (POS_EMB_DIM - 1) // 2
FILTER_FFN = 64
DECAY_TARGET = 1e-2
FAST_DECAY_PCT = 0.3
SLOW_DECAY_PCT = 1.5
MAX_DECAY = -math.log(DECAY_TARGET) / FAST_DECAY_PCT
MIN_DECAY = -math.log(DECAY_TARGET) / SLOW_DECAY_PCT
N_EXPERTS = 32
TOP_K = 4
D_FF = D_MODEL
SWIGLU_LIMIT = 7.0
SWIGLU_ALPHA = 1.702
EXPERT_BLOCK = 128
EPS = 1e-6
NEG_INF = -1e30

kernel_name = 'hymba_hyena_swa_moe_dit_layer'


def rmsnorm(x, g):
    xf = x.astype(jnp.float32)
    y = xf * lax.rsqrt(jnp.mean(xf * xf, axis=-1, keepdims=True) + EPS)
    return y.astype(x.dtype) * g


def modulate(h, shift, scale):
    return h * (1 + scale) + shift


def adaln(cond, w, b):
    return jax.nn.silu(cond) @ w + b


def split_projection(p):
    return jnp.split(p, [ATTN_WIDTH, ATTN_WIDTH + KV_WIDTH, ATTN_WIDTH + 2 * KV_WIDTH], axis=-1)


def axial_rope(x):
    L = x.shape[1]
    rows = L // GRID_W
    row = jnp.repeat(jnp.arange(rows, dtype=jnp.float32), GRID_W)
    col = jnp.tile(jnp.arange(GRID_W, dtype=jnp.float32), rows)
    half = HEAD_DIM // 2
    n_freq = half // 2
    inv_freq = ROPE_BASE ** (-jnp.arange(n_freq, dtype=jnp.float32) / n_freq)

    def rotate(xa, pos):
        ang = pos[:, None] * inv_freq[None, :]
        cos = jnp.cos(ang)[None, :, None, :].astype(x.dtype)
        sin = jnp.sin(ang)[None, :, None, :].astype(x.dtype)
        x1, x2 = xa[..., :n_freq], xa[..., n_freq:]
        return jnp.concatenate([x1 * cos - x2 * sin, x1 * sin + x2 * cos], axis=-1)

    return jnp.concatenate([rotate(x[..., :half], row), rotate(x[..., half:], col)], axis=-1)


def windowed_attention(q, k, v, kc, vc, sink):
    B, L = q.shape[:2]
    Lc = kc.shape[1]
    nb = L // ATTN_BLOCK
    nk = 3 * ATTN_BLOCK
    qb = q.reshape(B, nb, ATTN_BLOCK, N_KV_HEADS, GROUP, HEAD_DIM)

    def band(t):
        tp = jnp.pad(t, ((0, 0), (ATTN_BLOCK, ATTN_BLOCK), (0, 0), (0, 0)))
        tp = tp.reshape(B, nb + 2, ATTN_BLOCK, N_KV_HEADS, HEAD_DIM)
        return jnp.concatenate([tp[:, :-2], tp[:, 1:-1], tp[:, 2:]], axis=2)

    kw, vw = band(k), band(v)
    s_loc = jnp.einsum('bnqhgd,bnkhd->bnhgqk', qb, kw).astype(jnp.float32) * ATTN_SCALE
    i = jnp.arange(ATTN_BLOCK)[:, None]
    j = jnp.arange(nk)[None, :]
    key_pos = (jnp.arange(nb)[:, None, None] - 1) * ATTN_BLOCK + j[None]
    valid = (jnp.abs(j - ATTN_BLOCK - i) <= WINDOW)[None] & (key_pos >= 0) & (key_pos < L)
    s_loc = jnp.where(valid[None, :, None, None], s_loc, NEG_INF)
    s_ctx = jnp.einsum('bnqhgd,bchd->bnhgqc', qb, kc).astype(jnp.float32) * ATTN_SCALE
    s_sink = jnp.broadcast_to(sink.astype(jnp.float32).reshape(1, 1, N_KV_HEADS, GROUP, 1, 1),
                              s_loc.shape[:-1] + (1,))
    p = jax.nn.softmax(jnp.concatenate([s_loc, s_ctx, s_sink], axis=-1), axis=-1)
    p_loc = p[..., :nk].astype(v.dtype)
    p_ctx = p[..., nk:nk + Lc].astype(v.dtype)
    out = (jnp.einsum('bnhgqk,bnkhd->bnqhgd', p_loc, vw)
           + jnp.einsum('bnhgqc,bchd->bnqhgd', p_ctx, vc))
    return out.reshape(B, L, ATTN_WIDTH)


def context_attention(qc, kc, vc, sink):
    B, Lc = qc.shape[:2]
    qg = qc.reshape(B, Lc, N_KV_HEADS, GROUP, HEAD_DIM)
    s = jnp.einsum('bqhgd,bkhd->bhgqk', qg, kc).astype(jnp.float32) * ATTN_SCALE
    s_sink = jnp.broadcast_to(sink.astype(jnp.float32).reshape(1, N_KV_HEADS, GROUP, 1, 1),
                              s.shape[:-1] + (1,))
    p = jax.nn.softmax(jnp.concatenate([s, s_sink], axis=-1), axis=-1)[..., :Lc].astype(vc.dtype)
    return jnp.einsum('bhgqk,bkhd->bqhgd', p, vc).reshape(B, Lc, ATTN_WIDTH)


def short_conv(u, w, b):
    L = u.shape[1]
    pad = SHORT_CONV // 2
    up = jnp.pad(u, ((0, 0), (pad, pad), (0, 0)))
    y = b
    for tap in range(SHORT_CONV):
        y = y + up[:, tap:tap + L] * w[tap]
    return y


def implicit_filter(L, w1, b1, w2, b2, w3, b3, w4, freq):
    f32 = jnp.float32
    t = jnp.linspace(0.0, 1.0, L, dtype=f32)[:, None]
    w = 2.0 * math.pi * jnp.arange(L, dtype=f32)[:, None] / L
    bands = jnp.linspace(1e-4, POS_BANDS - 1, POS_BANDS, dtype=f32)[None, :]
    z = jnp.concatenate([t, jnp.cos(bands * w), -jnp.sin(bands * w)], axis=-1)
    fr = freq.astype(f32)
    h = jnp.sin(fr * (z @ w1.astype(f32) + b1.astype(f32)))
    h = jnp.sin(fr * (h @ w2.astype(f32) + b2.astype(f32)))
    h = jnp.sin(fr * (h @ w3.astype(f32) + b3.astype(f32)))
    k = h @ w4.astype(f32)
    deltas = jnp.linspace(MIN_DECAY, MAX_DECAY, HYENA_WIDTH, dtype=f32)
    decay = jnp.exp(-t * deltas[None, :])
    k_fwd = k[:, :HYENA_WIDTH] * decay
    k_bwd = k[:, HYENA_WIDTH:] * decay
    k_circ = jnp.concatenate([k_fwd, jnp.zeros((1, HYENA_WIDTH), f32), k_bwd[:0:-1]], axis=0)
    return k_circ * lax.rsqrt(jnp.sum(k_circ * k_circ, axis=0, keepdims=True) + EPS)


def bidir_fftconv(u, k_circ, bias):
    L = u.shape[1]
    n = 2 * L
    uf32 = u.astype(jnp.float32)
    uf = jnp.fft.rfft(uf32, n=n, axis=1)
    kf = jnp.fft.rfft(k_circ, n=n, axis=0)
    y = jnp.fft.irfft(uf * kf[None], n=n, axis=1)[:, :L]
    return (y + uf32 * bias.astype(jnp.float32)).astype(u.dtype)


def hyena_mixer(u, conv_w, conv_b, filt, filt_bias):
    L = u.shape[1]
    x0, x1, v = jnp.split(short_conv(u, conv_w, conv_b), 3, axis=-1)
    k_circ = implicit_filter(L, *filt)
    return x0 * bidir_fftconv(x1 * v, k_circ, filt_bias)


def merge_groups(a, y, g_a, g_y, w_out):
    return jnp.concatenate([rmsnorm(a, g_a), rmsnorm(y, g_y)], axis=-1) @ w_out


def moe(h, w_router, b_router, w_gu, b_gu, w_down, b_down):
    B, L, D = h.shape
    T = B * L
    ht = h.reshape(T, D)
    logits = (ht @ w_router + b_router).astype(jnp.float32)
    top_val, top_idx = lax.top_k(logits, TOP_K)
    gates = jax.nn.softmax(top_val, axis=-1)
    A = T * TOP_K
    flat_e = top_idx.reshape(A)
    flat_tok = jnp.arange(A, dtype=jnp.int32) // TOP_K
    flat_g = gates.reshape(A)
    order = jnp.argsort(flat_e)
    se = flat_e[order]
    counts = jnp.bincount(flat_e, length=N_EXPERTS)
    starts = jnp.cumsum(counts) - counts
    pcounts = (counts + EXPERT_BLOCK - 1) // EXPERT_BLOCK * EXPERT_BLOCK
    pends = jnp.cumsum(pcounts)
    pstarts = pends - pcounts
    dest = pstarts[se] + (jnp.arange(A, dtype=jnp.int32) - starts[se])
    n_blocks = (A + EXPERT_BLOCK - 1) // EXPERT_BLOCK + N_EXPERTS
    P = n_blocks * EXPERT_BLOCK
    slot_tok = jnp.full((P,), T, dtype=jnp.int32).at[dest].set(flat_tok[order])
    slot_g = jnp.zeros((P,), jnp.float32).at[dest].set(flat_g[order])
    block_e = jnp.minimum(jnp.searchsorted(pends, jnp.arange(n_blocks) * EXPERT_BLOCK, side='right'),
                          N_EXPERTS - 1)
    xs = jnp.concatenate([ht, jnp.zeros((1, D), ht.dtype)], axis=0)[slot_tok]
    xs = xs.reshape(n_blocks, EXPERT_BLOCK, D)

    def expert_block(args):
        xb, e = args
        gu = xb @ w_gu[e] + b_gu[e]
        gate, up = gu[:, :D_FF], gu[:, D_FF:]
        gate = jnp.minimum(gate, SWIGLU_LIMIT)
        up = jnp.clip(up, -SWIGLU_LIMIT, SWIGLU_LIMIT)
        glu = gate * jax.nn.sigmoid(SWIGLU_ALPHA * gate)
        return ((up + 1) * glu) @ w_down[e] + b_down[e]

    ys = lax.map(expert_block, (xs, block_e)).reshape(P, D)
    out = jax.ops.segment_sum(ys * slot_g[:, None].astype(ys.dtype), slot_tok, num_segments=T + 1)[:T]
    return out.reshape(B, L, D)


def setup_inputs(seed: int = 0) -> dict:
    key = jax.random.key(seed)
    ks = jax.random.split(key, 40)

    def normal(idx, shape, scale=1.0):
        return scale * jax.random.normal(ks[idx], shape, jnp.float32)

    def gain(idx, shape):
        return 1.0 + normal(idx, shape, 0.02)

    return {
        'x': normal(0, (BATCH, SEQ, D_MODEL)),
        'c': normal(1, (BATCH, D_MODEL)),
        'ctx': normal(2, (BATCH, CTX_LEN, D_MODEL)),
        'c_ctx': normal(3, (D_MODEL,)),
        'w_mod': normal(4, (DEPTH, D_MODEL, 6 * D_MODEL), D_MODEL ** -0.5),
        'b_mod': normal(5, (DEPTH, 6 * D_MODEL), 0.01),
        'norm1': gain(6, (DEPTH, D_MODEL)),
        'norm2': gain(7, (DEPTH, D_MODEL)),
        'w_in': normal(8, (DEPTH, D_MODEL, IN_WIDTH), D_MODEL ** -0.5),
        'q_norm': gain(9, (DEPTH, HEAD_DIM)),
        'k_norm': gain(10, (DEPTH, HEAD_DIM)),
        'sink': normal(11, (DEPTH, N_Q_HEADS), 0.5),
        'conv_w': normal(12, (DEPTH, SHORT_CONV, 3 * HYENA_WIDTH), SHORT_CONV ** -0.5),
        'conv_b': normal(13, (DEPTH, 3 * HYENA_WIDTH), 0.01),
        'filt_w1': normal(14, (DEPTH, POS_EMB_DIM, FILTER_FFN), POS_EMB_DIM ** -0.5),
        'filt_b1': normal(15, (DEPTH, FILTER_FFN), 0.1),
        'filt_w2': normal(16, (DEPTH, FILTER_FFN, FILTER_FFN), FILTER_FFN ** -0.5),
        'filt_b2': normal(17, (DEPTH, FILTER_FFN), 0.1),
        'filt_w3': normal(18, (DEPTH, FILTER_FFN, FILTER_FFN), FILTER_FFN ** -0.5),
        'filt_b3': normal(19, (DEPTH, FILTER_FFN), 0.1),
        'filt_w4': normal(20, (DEPTH, FILTER_FFN, 2 * HYENA_WIDTH), FILTER_FFN ** -0.5),
        'filt_freq': gain(21, (DEPTH, FILTER_FFN)),
        'filt_bias': normal(22, (DEPTH, HYENA_WIDTH), 0.1),
        'attn_out_norm': gain(23, (DEPTH, ATTN_WIDTH)),
        'hyena_out_norm': gain(24, (DEPTH, HYENA_WIDTH)),
        'w_out': normal(25, (DEPTH, MIX_WIDTH, D_MODEL), MIX_WIDTH ** -0.5),
        'w_router': normal(26, (DEPTH, D_MODEL, N_EXPERTS), D_MODEL ** -0.5),
        'b_router': normal(27, (DEPTH, N_EXPERTS), 0.01),
        'w_gu': normal(28, (DEPTH, N_EXPERTS, D_MODEL, 2 * D_FF), D_MODEL ** -0.5),
        'b_gu': normal(29, (DEPTH, N_EXPERTS, 2 * D_FF), 0.01),
        'w_down': normal(30, (DEPTH, N_EXPERTS, D_FF, D_MODEL), D_FF ** -0.5),
        'b_down': normal(31, (DEPTH, N_EXPERTS, D_MODEL), 0.01),
    }


def reference(x, c, ctx, c_ctx, w_mod, b_mod, norm1, norm2, w_in, q_norm, k_norm, sink,
              conv_w, conv_b, filt_w1, filt_b1, filt_w2, filt_b2, filt_w3, filt_b3, filt_w4,
              filt_freq, filt_bias, attn_out_norm, hyena_out_norm, w_out,
              w_router, b_router, w_gu, b_gu, w_down, b_down):
    B, L, _ = x.shape
    Lc = ctx.shape[1]
    for l in range(DEPTH):
        last = l == DEPTH - 1
        mod = adaln(c, w_mod[l], b_mod[l])[:, None, :]
        mod_c = adaln(c_ctx[None], w_mod[l], b_mod[l])[:, None, :]
        sh1, sc1, g1, sh2, sc2, g2 = jnp.split(mod, 6, axis=-1)
        csh1, csc1, cg1, csh2, csc2, cg2 = jnp.split(mod_c, 6, axis=-1)
        filt = (filt_w1[l], filt_b1[l], filt_w2[l], filt_b2[l], filt_w3[l], filt_b3[l],
                filt_w4[l], filt_freq[l])
        experts = (w_router[l], b_router[l], w_gu[l], b_gu[l], w_down[l], b_down[l])

        h = modulate(rmsnorm(x, norm1[l]), sh1, sc1)
        q, k, v, u = split_projection(h @ w_in[l])
        q = axial_rope(rmsnorm(q.reshape(B, L, N_Q_HEADS, HEAD_DIM), q_norm[l]))
        k = axial_rope(rmsnorm(k.reshape(B, L, N_KV_HEADS, HEAD_DIM), k_norm[l]))
        v = v.reshape(B, L, N_KV_HEADS, HEAD_DIM)

        hc = modulate(rmsnorm(ctx, norm1[l]), csh1, csc1)
        if last:
            kc, vc = jnp.split(hc @ w_in[l][:, ATTN_WIDTH:ATTN_WIDTH + 2 * KV_WIDTH], 2, axis=-1)
        else:
            qc, kc, vc, uc = split_projection(hc @ w_in[l])
        kc = rmsnorm(kc.reshape(B, Lc, N_KV_HEADS, HEAD_DIM), k_norm[l])
        vc = vc.reshape(B, Lc, N_KV_HEADS, HEAD_DIM)

        a = windowed_attention(q, k, v, kc, vc, sink[l])
        y = hyena_mixer(u, conv_w[l], conv_b[l], filt, filt_bias[l])
        x_new = x + g1 * merge_groups(a, y, attn_out_norm[l], hyena_out_norm[l], w_out[l])
        x_new = x_new + g2 * moe(modulate(rmsnorm(x_new, norm2[l]), sh2, sc2), *experts)

        if not last:
            qc = rmsnorm(qc.reshape(B, Lc, N_Q_HEADS, HEAD_DIM), q_norm[l])
            ac = context_attention(qc, kc, vc, sink[l])
            yc = hyena_mixer(uc, conv_w[l], conv_b[l], filt, filt_bias[l])
            ctx = ctx + cg1 * merge_groups(ac, yc, attn_out_norm[l], hyena_out_norm[l], w_out[l])
            ctx = ctx + cg2 * moe(modulate(rmsnorm(ctx, norm2[l]), csh2, csc2), *experts)
        x = x_new
    return x
```

```cpp
#include <hip/hip_runtime.h>
#include <hip/hip_cooperative_groups.h>
#include <cstdio>
#include <cstdint>
#include <cmath>
namespace cg = cooperative_groups;
#ifndef PROBE_A
#define PROBE_A -1
#endif
#ifndef PROBE_B
#define PROBE_B -1
#endif
namespace pg8 {
#define PG8_LAS __attribute__((address_space(3)))
typedef unsigned short bf16_t;
typedef short bf16x8 __attribute__((ext_vector_type(8)));
typedef float f32x4 __attribute__((ext_vector_type(4)));
typedef unsigned u32x4 __attribute__((ext_vector_type(4)));
constexpr int BM = 256, BK = 64, HALF = 128, HTB = HALF * BK * 2  , STAGE_BYTES = 8 * HTB, NXCD = 8, WGM = 8;

__host__ __device__ __forceinline__ int lds_byte(int r, int c) { const int st = (r >> 4) * 2 + (c >> 5), rr = r & 15, cc = c & 31, ob = rr * 64 + cc * 2; return st * 1024 + (ob ^ (((ob >> 9) & 1) << 5)); }
__host__ __device__ __forceinline__ void stage_rc(int b, int& R, int& C) { const int st = b / 1024, sb = b % 1024, swz = sb ^ (((sb >> 9) & 1) << 5); R = (st >> 1) * 16 + swz / 64; C = (st & 1) * 32 + (swz % 64) / 2; }
__host__ __device__ __forceinline__ int perm32(int rho) { const int n = rho >> 4, i = rho & 15; return 8 * (i >> 2) + 4 * n + (i & 3); }

struct Unit { int pm, pn, e; };
struct Gemm { const bf16_t* A; const bf16_t* Bt; int M, N, K; };

struct StaticOrder {
    int nM, nN, nwg, G, c;
    __host__ __device__ void init(int M, int N, int G_, int c_) { nM = M / BM; nN = N / BM; nwg = nM * nN; G = G_; c = c_; }
    __host__ __device__ bool next(int i, Unit& u) const {
        const long L = (long)i * G + c; if (L >= nwg) return false;
        int wgid = (int)L; { const int q = nwg / NXCD, r = nwg % NXCD, xcd = wgid % NXCD, off = wgid / NXCD; wgid = (xcd < r ? xcd * (q + 1) : r * (q + 1) + (xcd - r) * q) + off; }
        const int nig = WGM * nN, gid = wgid / nig, fm = gid * WGM, gsz = (nM - fm) < WGM ? (nM - fm) : WGM;
        u.pm = fm + ((wgid % nig) % gsz); u.pn = (wgid % nig) / gsz; u.e = 0; return true;
    }
    __device__ __forceinline__ size_t a_off(const Unit& u, size_t tstep) const { return (size_t)u.pm * tstep; }
    __device__ __forceinline__ size_t b_off(const Unit& u, size_t tstep) const { return (size_t)u.pn * tstep; }
    __device__ __forceinline__ void a_ready(const Unit&) const {}
    __device__ __forceinline__ void done(const Unit&) const {}
};

__device__ __forceinline__ unsigned cvt_pk_bf16(float lo, float hi) { unsigned r; asm volatile("v_cvt_pk_bf16_f32 %0, %1, %2" : "=v"(r) : "v"(lo), "v"(hi)); return r; }

template <class Epi, class Sched, bool ALIGN_EPI = false, bool SP2 = false>
__device__ __forceinline__ void gemm_phase(PG8_LAS unsigned char* lds, const Gemm g, const Sched& S, const Epi& E) {
    const int tid = threadIdx.x, wid = __builtin_amdgcn_readfirstlane(tid >> 6), lane = tid & 63, wr = wid >> 2, wc = wid & 3, fr = lane & 15, fq = lane >> 4;
    const int K = g.K, nt = K / BK;
    unsigned voffA[2], voffB[2];
#pragma unroll
    for (int i = 0; i < 2; ++i) { int R, C; stage_rc(tid * 16 + i * 8192, R, C); const int Rb = Epi::PERM ? ((R & ~31) + perm32(R & 31)) : R;
        voffA[i] = (unsigned)(R * K + C) * 2u; voffB[i] = (unsigned)(Rb * K + C) * 2u; }
    const size_t kstep = (size_t)(BK * 2);
    const size_t hstep = (size_t)HALF * K * 2;
    const size_t tstep = 2 * hstep;
    const unsigned ldsw = (unsigned)wid * 1024u;
    const int aoff = lds_byte(wr * 64 + fr, fq * 8), boff = lds_byte(wc * 32 + fr, fq * 8);
#define PG8_SA(b, h) (((b) * 2 + (h)) * HTB)
#define PG8_SB(b, h) ((4 + (b) * 2 + (h)) * HTB)
#define PG8_STAGE(bufoff, gbase, voff) do { _Pragma("unroll") for (int _i = 0; _i < 2; ++_i) \
        __builtin_amdgcn_global_load_lds((const unsigned*)((const char*)(gbase) + (voff)[_i]), (PG8_LAS unsigned*)(lds + (bufoff) + ldsw + _i * 8192), 16, 0, 0); } while (0)
#define PG8_LDA(dst, b, h) do { _Pragma("unroll") for (int m = 0; m < 4; ++m) _Pragma("unroll") for (int k = 0; k < 2; ++k) dst[m][k] = *(const PG8_LAS bf16x8*)(lds + PG8_SA(b, h) + aoff + m * 2048 + k * 1024); } while (0)
#define PG8_LDB(dst, b, h) do { _Pragma("unroll") for (int n = 0; n < 2; ++n) _Pragma("unroll") for (int k = 0; k < 2; ++k) dst[n][k] = *(const PG8_LAS bf16x8*)(lds + PG8_SB(b, h) + boff + n * 2048 + k * 1024); } while (0)
#define PG8_MMA(ai, bj, At, Bt) do { __builtin_amdgcn_s_setprio(1); _Pragma("unroll") for (int m = 0; m < 4; ++m) _Pragma("unroll") for (int n = 0; n < 2; ++n) _Pragma("unroll") for (int k = 0; k < 2; ++k) \
        acc[ai][bj][m][n] = __builtin_amdgcn_mfma_f32_16x16x32_bf16(Bt[n][k], At[m][k], acc[ai][bj][m][n], 0, 0, 0); __builtin_amdgcn_s_setprio(0); } while (0)
#define PG8_WAIT_V(n) asm volatile("s_waitcnt vmcnt(" #n ")" ::: "memory")
#define PG8_WAIT_L(n) asm volatile("s_waitcnt lgkmcnt(" #n ")" ::: "memory")
#define PG8_BAR __builtin_amdgcn_s_barrier()
#define PG8_SCHED __builtin_amdgcn_sched_barrier(0)
    Unit cur, nxt; int ui = 0;
    if (!S.next(0, cur)) return;
    f32x4 acc[2][2][4][2];
#pragma unroll
    for (int a = 0; a < 2; ++a)
#pragma unroll
        for (int b = 0; b < 2; ++b)
#pragma unroll
            for (int m = 0; m < 4; ++m)
#pragma unroll
                for (int n = 0; n < 2; ++n) acc[a][b][m][n] = (f32x4){0.f, 0.f, 0.f, 0.f};
    bf16x8 At[4][2], B0[2][2], B1[2][2];
    const char* cA = (const char*)g.A + S.a_off(cur, tstep); const char* cB = (const char*)g.Bt + S.b_off(cur, tstep);
    S.a_ready(cur);
    if constexpr (SP2) {
        PG8_STAGE(PG8_SB(0, 0), cB, voffB); PG8_STAGE(PG8_SB(0, 1), cB + hstep, voffB); PG8_STAGE(PG8_SA(0, 0), cA, voffA); PG8_STAGE(PG8_SA(0, 1), cA + hstep, voffA);
        if (wr == 1) PG8_BAR;
        PG8_WAIT_V(2); PG8_BAR;
        PG8_STAGE(PG8_SB(1, 0), cB + kstep, voffB); PG8_STAGE(PG8_SA(1, 0), cA + kstep, voffA); PG8_STAGE(PG8_SB(1, 1), cB + hstep + kstep, voffB);
        PG8_WAIT_V(6); PG8_BAR;
    } else {
        PG8_STAGE(PG8_SB(0, 0), cB, voffB); PG8_STAGE(PG8_SA(0, 0), cA, voffA); PG8_STAGE(PG8_SB(0, 1), cB + hstep, voffB); PG8_STAGE(PG8_SA(0, 1), cA + hstep, voffA);
        if (wr == 1) PG8_BAR;
        PG8_WAIT_V(4); PG8_BAR;
        PG8_STAGE(PG8_SB(1, 0), cB + kstep, voffB); PG8_STAGE(PG8_SA(1, 0), cA + kstep, voffA); PG8_STAGE(PG8_SB(1, 1), cB + hstep + kstep, voffB);
        PG8_WAIT_V(6); PG8_BAR;
    }
    for (;;) {
        const bool has_next = S.next(ui + 1, nxt);
        const char* nA = has_next ? (const char*)g.A + S.a_off(nxt, tstep) : cA; const char* nB = has_next ? (const char*)g.Bt + S.b_off(nxt, tstep) : cB;
        for (int t = 0; t < nt; t += 2) {
            const bool last = (t == nt - 2);
            const char* a1 = cA + (size_t)(t + 1) * kstep;
            const char* a2 = last ? nA : cA + (size_t)(t + 2) * kstep; const char* b2 = last ? nB : cB + (size_t)(t + 2) * kstep;
            const char* a3 = a2 + kstep; const char* b3 = b2 + kstep;
            if (last && has_next) S.a_ready(nxt);
            if constexpr (SP2) {
            PG8_LDB(B0, 0, 0); PG8_LDB(B1, 0, 1); PG8_SCHED; PG8_LDA(At, 0, 0); PG8_STAGE(PG8_SA(1, 1), a1 + hstep, voffA);
            PG8_WAIT_V(8); PG8_WAIT_L(0); PG8_BAR; PG8_MMA(0, 0, At, B0); PG8_MMA(0, 1, At, B1); PG8_BAR; PG8_SCHED;
            PG8_LDA(At, 0, 1); PG8_STAGE(PG8_SB(0, 0), b2, voffB); PG8_STAGE(PG8_SB(0, 1), b2 + hstep, voffB); PG8_STAGE(PG8_SA(0, 0), a2, voffA);
            PG8_WAIT_V(8); PG8_WAIT_L(0); PG8_BAR; PG8_MMA(1, 0, At, B0); PG8_MMA(1, 1, At, B1); PG8_BAR; PG8_SCHED;
            PG8_LDB(B0, 1, 0); PG8_LDB(B1, 1, 1); PG8_SCHED; PG8_LDA(At, 1, 0); PG8_STAGE(PG8_SA(0, 1), a2 + hstep, voffA);
            PG8_WAIT_V(8); PG8_WAIT_L(0); PG8_BAR; PG8_MMA(0, 0, At, B0); PG8_MMA(0, 1, At, B1); PG8_BAR; PG8_SCHED;
            PG8_LDA(At, 1, 1); PG8_STAGE(PG8_SB(1, 0), b3, voffB); PG8_STAGE(PG8_SB(1, 1), b3 + hstep, voffB); PG8_STAGE(PG8_SA(1, 0), a3, voffA);
            PG8_WAIT_V(8); PG8_WAIT_L(0); PG8_BAR; PG8_MMA(1, 0, At, B0); PG8_MMA(1, 1, At, B1); PG8_BAR; PG8_SCHED;
            } else {
            PG8_LDB(B0, 0, 0); PG8_SCHED; PG8_LDA(At, 0, 0); PG8_STAGE(PG8_SA(1, 1), a1 + hstep, voffA);
            PG8_WAIT_L(8); PG8_BAR; PG8_WAIT_L(0); PG8_MMA(0, 0, At, B0); PG8_BAR; PG8_SCHED;
            PG8_LDB(B1, 0, 1); PG8_STAGE(PG8_SB(0, 0), b2, voffB);
            PG8_BAR; PG8_WAIT_L(0); PG8_MMA(0, 1, At, B1); PG8_BAR;
            PG8_LDA(At, 0, 1); PG8_STAGE(PG8_SA(0, 0), a2, voffA);
            PG8_BAR; PG8_WAIT_L(0); PG8_MMA(1, 0, At, B0); PG8_BAR; PG8_SCHED;
            PG8_STAGE(PG8_SB(0, 1), b2 + hstep, voffB);
            PG8_WAIT_V(6); PG8_BAR; PG8_MMA(1, 1, At, B1); PG8_BAR;
            PG8_LDB(B0, 1, 0); PG8_SCHED; PG8_LDA(At, 1, 0); PG8_STAGE(PG8_SA(0, 1), a2 + hstep, voffA);
            PG8_WAIT_L(8); PG8_BAR; PG8_WAIT_L(0); PG8_MMA(0, 0, At, B0); PG8_BAR; PG8_SCHED;
            PG8_LDB(B1, 1, 1); PG8_STAGE(PG8_SB(1, 0), b3, voffB);
            PG8_BAR; PG8_WAIT_L(0); PG8_MMA(0, 1, At, B1); PG8_BAR;
            PG8_LDA(At, 1, 1); PG8_STAGE(PG8_SA(1, 0), a3, voffA);
            PG8_BAR; PG8_WAIT_L(0); PG8_MMA(1, 0, At, B0); PG8_BAR; PG8_SCHED;
            PG8_STAGE(PG8_SB(1, 1), b3 + hstep, voffB);
            PG8_WAIT_V(6); PG8_BAR; PG8_MMA(1, 1, At, B1); PG8_BAR;
            }
        }
        if constexpr (ALIGN_EPI) { if (wr == 0) PG8_BAR; }
        if constexpr (!Epi::AFTER_DRAIN) { E(acc, cur, wr, wc, fr, fq); S.done(cur); }
        if (!has_next) break;
#pragma unroll
        for (int a = 0; a < 2; ++a)
#pragma unroll
            for (int b = 0; b < 2; ++b)
#pragma unroll
                for (int m = 0; m < 4; ++m)
#pragma unroll
                    for (int n = 0; n < 2; ++n) acc[a][b][m][n] = (f32x4){0.f, 0.f, 0.f, 0.f};
        cur = nxt; cA = nA; cB = nB; ++ui;
        if constexpr (ALIGN_EPI) { if (wr == 1) PG8_BAR; }
    }
    PG8_WAIT_V(0);
    if constexpr (!ALIGN_EPI) { if (wr == 0) PG8_BAR; }
    PG8_BAR;
    if constexpr (Epi::AFTER_DRAIN) { E.fused(acc, cur, wr, wc, fr, fq, lds, wid, lane); S.done(cur); }
#undef PG8_SA
#undef PG8_SB
#undef PG8_STAGE
#undef PG8_LDA
#undef PG8_LDB
#undef PG8_MMA
#undef PG8_WAIT_V
#undef PG8_WAIT_L
#undef PG8_BAR
#undef PG8_SCHED
}
}
namespace pg8 {
typedef unsigned u32x4 __attribute__((ext_vector_type(4)));
struct EpiStore {
    static constexpr bool PERM = true, AFTER_DRAIN = false;
    bf16_t* O; int ldc;
    __device__ __forceinline__ void operator()(const f32x4 (&acc)[2][2][4][2], const Unit& u, int wr, int wc, int fr, int fq) const {
        const int row0 = u.pm * BM + wr * 64 + fr; const int col0 = u.pn * BM + wc * 32 + 8 * fq;
#pragma unroll
        for (int ai = 0; ai < 2; ++ai)
#pragma unroll
            for (int m = 0; m < 4; ++m) { bf16_t* rowp = O + (size_t)(row0 + ai * HALF + m * 16) * ldc + col0;
#pragma unroll
                for (int bj = 0; bj < 2; ++bj) { const f32x4 v0 = acc[ai][bj][m][0], v1 = acc[ai][bj][m][1];
                    u32x4 w; w.x = cvt_pk_bf16(v0[0], v0[1]); w.y = cvt_pk_bf16(v0[2], v0[3]); w.z = cvt_pk_bf16(v1[0], v1[1]); w.w = cvt_pk_bf16(v1[2], v1[3]);
                    *(u32x4*)(rowp + bj * HALF) = w; } }
    }
};
struct EpiStoreBias {
    static constexpr bool PERM = true, AFTER_DRAIN = false;
    bf16_t* O; int ldc; const float* bias; int bstride;
    __device__ __forceinline__ void operator()(const f32x4 (&acc)[2][2][4][2], const Unit& u, int wr, int wc, int fr, int fq) const {
        const int row0 = u.pm * BM + wr * 64 + fr; const int col0 = u.pn * BM + wc * 32 + 8 * fq;
        const float* bp = bias + (size_t)u.e * bstride + col0;
        f32x4 bv[2][2];
#pragma unroll
        for (int bj = 0; bj < 2; ++bj)
#pragma unroll
            for (int n = 0; n < 2; ++n) bv[bj][n] = *(const f32x4*)(bp + bj * HALF + 4 * n);
#pragma unroll
        for (int ai = 0; ai < 2; ++ai)
#pragma unroll
            for (int m = 0; m < 4; ++m) { bf16_t* rowp = O + (size_t)(row0 + ai * HALF + m * 16) * ldc + col0;
#pragma unroll
                for (int bj = 0; bj < 2; ++bj) { const f32x4 v0 = acc[ai][bj][m][0] + bv[bj][0], v1 = acc[ai][bj][m][1] + bv[bj][1];
                    u32x4 w; w.x = cvt_pk_bf16(v0[0], v0[1]); w.y = cvt_pk_bf16(v0[2], v0[3]); w.z = cvt_pk_bf16(v1[0], v1[1]); w.w = cvt_pk_bf16(v1[2], v1[3]);
                    *(u32x4*)(rowp + bj * HALF) = w; } }
    }
};
struct EpiResid {
    static constexpr bool PERM = false, AFTER_DRAIN = false;
    const float* x; float* out; const float* mod;
    __device__ __forceinline__ void operator()(const f32x4 (&acc)[2][2][4][2], const Unit& u, int wr, int wc, int fr, int fq) const {
        const int col0 = u.pn * BM + wc * 32 + 4 * fq;
        const int b = (u.pm * BM) >> 12;
        const float* g1 = mod + (size_t)b * 6144 + 2048 + col0;
        f32x4 gv[2][2];
#pragma unroll
        for (int bj = 0; bj < 2; ++bj)
#pragma unroll
            for (int n = 0; n < 2; ++n) gv[bj][n] = *(const f32x4*)(g1 + bj * HALF + n * 16);
#pragma unroll
        for (int ai = 0; ai < 2; ++ai)
#pragma unroll
            for (int m = 0; m < 4; ++m) { const size_t off = (size_t)(u.pm * BM + ai * HALF + wr * 64 + m * 16 + fr) * 1024 + col0;
#pragma unroll
                for (int bj = 0; bj < 2; ++bj)
#pragma unroll
                    for (int n = 0; n < 2; ++n) { const f32x4 xv = *(const f32x4*)(x + off + bj * HALF + n * 16);
                        *(f32x4*)(out + off + bj * HALF + n * 16) = xv + gv[bj][n] * acc[ai][bj][m][n]; } }
    }
};
struct EpiSwiglu {
    static constexpr bool PERM = true, AFTER_DRAIN = false;
    bf16_t* O; const float* bgu;
    __device__ __forceinline__ void operator()(const f32x4 (&acc)[2][2][4][2], const Unit& u, int wr, int wc, int fr, int fq) const {
        const int row0 = u.pm * BM + wr * 64 + fr; const int hc0 = u.pn * HALF + wc * 32 + 8 * fq;
        const float* bg = bgu + (size_t)u.e * 2048 + hc0;
        f32x4 bgv[2], buv[2];
#pragma unroll
        for (int n = 0; n < 2; ++n) { bgv[n] = *(const f32x4*)(bg + 4 * n); buv[n] = *(const f32x4*)(bg + 1024 + 4 * n); }
#pragma unroll
        for (int ai = 0; ai < 2; ++ai)
#pragma unroll
            for (int m = 0; m < 4; ++m) { bf16_t* rowp = O + (size_t)(row0 + ai * HALF + m * 16) * 1024 + hc0;
                float h[8];
#pragma unroll
                for (int n = 0; n < 2; ++n) { const f32x4 g4 = acc[ai][0][m][n] + bgv[n], u4 = acc[ai][1][m][n] + buv[n];
#pragma unroll
                    for (int j = 0; j < 4; ++j) { const float g = fminf(g4[j], 7.0f); const float up = fminf(fmaxf(u4[j], -7.0f), 7.0f);
                        const float glu = g / (1.0f + __expf(-1.702f * g)); h[4 * n + j] = (up + 1.0f) * glu; } }
                u32x4 w; w.x = cvt_pk_bf16(h[0], h[1]); w.y = cvt_pk_bf16(h[2], h[3]); w.z = cvt_pk_bf16(h[4], h[5]); w.w = cvt_pk_bf16(h[6], h[7]);
                *(u32x4*)rowp = w; }
    }
};
struct MoeOrder {
    const PG8_LAS int* tstart; int nN, G, c; size_t estride;
    __device__ __forceinline__ bool next(int i, Unit& u) const {
        const int nMt = tstart[32]; const long L = (long)i * G + c; if (L >= (long)nMt * nN) return false;
        const int pm = (int)(L / nN), pn = (int)(L % nN); int e = 0;
#pragma unroll 1
        for (int k = 1; k < 32; ++k) e += (pm >= tstart[k]) ? 1 : 0;
        u.pm = __builtin_amdgcn_readfirstlane(pm); u.pn = __builtin_amdgcn_readfirstlane(pn); u.e = __builtin_amdgcn_readfirstlane(e); return true;
    }
    __device__ __forceinline__ size_t a_off(const Unit& u, size_t tstep) const { return (size_t)u.pm * tstep; }
    __device__ __forceinline__ size_t b_off(const Unit& u, size_t tstep) const { return (size_t)u.e * estride + (size_t)u.pn * tstep; }
    __device__ __forceinline__ void a_ready(const Unit&) const {}
    __device__ __forceinline__ void done(const Unit&) const {}
};
}

constexpr int NB = 8, SEQ = 4096, DM = 1024, T = NB * SEQ, LC = 256, TC = NB * LC, MROWS = T + TC;
constexpr int INW = 2304, AW = 512, HW = 512, HD = 64, NE = 32, TOPK = 4;
constexpr float EPS = 1e-6f;
constexpr int PMAX = T * TOPK + NE * 256;
constexpr int NWAVES = 8, NTHR = 512;

constexpr size_t MiB = 1u << 20;
constexpr size_t WS_CTL = 0, CTL_ZERO_BYTES = 1 * MiB;
constexpr size_t WS_MOD = 1 * MiB;
constexpr size_t WS_WIN = 2 * MiB;
constexpr size_t WS_WOUT = 8 * MiB;
constexpr size_t WS_RG = 10 * MiB;
constexpr size_t WS_ROUTE = 18 * MiB;
constexpr size_t WS_WGU = 32 * MiB;
constexpr size_t WS_WD = 160 * MiB;
constexpr size_t WS_H1 = 224 * MiB;
constexpr size_t WS_PROJ = 296 * MiB;
constexpr size_t WS_A2 = 452 * MiB;
constexpr size_t WS_HID = 296 * MiB;
constexpr size_t WS_XS = 568 * MiB;
constexpr size_t WS_ZT = 840 * MiB;
constexpr size_t WS_X0T = 872 * MiB;
constexpr size_t WS_YT = 904 * MiB;
constexpr size_t WS_ATT = 936 * MiB;
constexpr size_t WS_END = 1000 * MiB;
constexpr int CW_CNT = 64;
constexpr int CW_NRM = 128;
constexpr int CW_BAR = 4096;
constexpr int CW_TS_BYTES = 65536;

constexpr int LDS_BYTES = 147456;
constexpr int RING_BYTES = 131072;
constexpr int MISC_OFF = RING_BYTES;

#define GAS __attribute__((address_space(1)))
#define LAS __attribute__((address_space(3)))
typedef unsigned short bf16;
typedef unsigned v4u __attribute__((ext_vector_type(4)));
typedef unsigned v2u __attribute__((ext_vector_type(2)));
typedef float f32x4 __attribute__((ext_vector_type(4)));
typedef short bf16x8 __attribute__((ext_vector_type(8)));

__device__ __forceinline__ unsigned f2bf(float f) { unsigned u = __builtin_bit_cast(unsigned, f); return (u + 0x7fffu + ((u >> 16) & 1u)) >> 16; }
__device__ __forceinline__ unsigned pk2(float lo, float hi) { return f2bf(lo) | (f2bf(hi) << 16); }
__device__ __forceinline__ float bf2f(unsigned h) { return __builtin_bit_cast(float, h << 16); }
__device__ __forceinline__ float bflo(unsigned w) { return __builtin_bit_cast(float, w << 16); }
__device__ __forceinline__ float bfhi(unsigned w) { return __builtin_bit_cast(float, w & 0xffff0000u); }
__device__ __forceinline__ float wave_sum(float v) {
#pragma unroll
    for (int o = 1; o < 64; o <<= 1) v += __shfl_xor(v, o);
    return v;
}
__device__ __forceinline__ float wave_max(float v) {
#pragma unroll
    for (int o = 1; o < 64; o <<= 1) v = fmaxf(v, __shfl_xor(v, o));
    return v;
}
#define LDS_FENCE() asm volatile("s_waitcnt lgkmcnt(0)" ::: "memory")

struct Args { const float* in[32]; float* out; unsigned char* ws; int ph_lo, ph_hi; };

struct Frame {
    LAS unsigned char* lds;
    int tid, lane, wave, gw, ngw;
    const float* in[32];
    float* out; unsigned char* ws;
};
#define XB_TMO      128
#define XB_XCNT(j)  (256  + 64 * (j))
#define XB_XSUB(j)  (1280 + 64 * (j))
#define XB_XGEN(j)  (2304 + 64 * (j))
#define XB_TOP      3328
#define XB_TOPGEN   3392
#define XCD_BAR_WORDS 3456
#define XB_SPIN_CAP (1u << 18)

__device__ __forceinline__ unsigned xb_ld(unsigned* p)              { return __hip_atomic_load(p, __ATOMIC_RELAXED, __HIP_MEMORY_SCOPE_AGENT); }
__device__ __forceinline__ unsigned xb_add(unsigned* p, unsigned v) { return __hip_atomic_fetch_add(p, v, __ATOMIC_RELAXED, __HIP_MEMORY_SCOPE_AGENT); }
__device__ __forceinline__ unsigned xb_xcc_id() { return (unsigned)__builtin_amdgcn_s_getreg((3 << 11) | 20) & 0xFu; }
#define XB_SPIN(cond, bar) do { unsigned _sp = 0; while (cond) { __builtin_amdgcn_s_sleep(1); \
    if ((++_sp & 255u) == 0u) { if (xb_ld(&(bar)[XB_TMO])) break; if (_sp > XB_SPIN_CAP) { atomicAdd(&(bar)[XB_TMO], 1u); break; } } } } while (0)

struct XcdBarrier {
    unsigned* bar; unsigned x;
    volatile LAS unsigned* st;
};

__device__ __forceinline__ XcdBarrier xcd_barrier_post(unsigned* bar, volatile LAS unsigned* st) {
    XcdBarrier b; b.bar = bar; b.x = xb_xcc_id(); b.st = st;
    if (threadIdx.x == 0) (void)xb_add(&bar[XB_XCNT(b.x)], 1u);
    return b;
}
__device__ __forceinline__ void xcd_barrier_complete(unsigned* bar, unsigned x, unsigned& nloc, unsigned& nx) {
    const unsigned G = gridDim.x * gridDim.y * gridDim.z;
    unsigned sum, cnt, mine, sp = 0u;
    for (;;) {
        sum = 0u; cnt = 0u; mine = 0u;
#pragma unroll
        for (unsigned j = 0; j < 16; ++j) { const unsigned c = xb_ld(&bar[XB_XCNT(j)]); sum += c; cnt += (c > 0u) ? 1u : 0u; mine = (j == x) ? c : mine; }
        if (sum == G) break;
        __builtin_amdgcn_s_sleep(1);
        if ((++sp & 255u) == 0u) { if (xb_ld(&bar[XB_TMO])) break; if (sp > XB_SPIN_CAP) { atomicAdd(&bar[XB_TMO], 1u); break; } }
    }
    nloc = mine > 0u ? mine : 1u; nx = cnt > 0u ? cnt : 1u;
}

__device__ __forceinline__ void xcd_barrier(const XcdBarrier& b) {
    asm volatile("s_waitcnt vmcnt(0)" ::: "memory");
    __syncthreads();
    if (threadIdx.x == 0) {
        unsigned* bar = b.bar;
        __builtin_amdgcn_s_waitcnt(0);
        unsigned nloc = b.st[0], nx = b.st[1];
        if (nloc == 0u) { xcd_barrier_complete(bar, b.x, nloc, nx); b.st[0] = nloc; b.st[1] = nx; }
        const unsigned old = xb_add(&bar[XB_XSUB(b.x)], 1u);
        const unsigned gen = old / nloc;
        if (old + 1u == (gen + 1u) * nloc) {
            __builtin_amdgcn_fence(__ATOMIC_RELEASE, "agent");
            asm volatile("s_waitcnt vmcnt(0)" ::: "memory");
            const unsigned og = xb_add(&bar[XB_TOP], 1u);
            const unsigned tg = og / nx;
            if (og + 1u == (tg + 1u) * nx) xb_add(&bar[XB_TOPGEN], 1u);
            else XB_SPIN(xb_ld(&bar[XB_TOPGEN]) == tg, bar);
            __builtin_amdgcn_fence(__ATOMIC_ACQUIRE, "agent");
            xb_add(&bar[XB_XGEN(b.x)], 1u);
            asm volatile("s_waitcnt vmcnt(0)" ::: "memory");
        } else {
            XB_SPIN(xb_ld(&bar[XB_XGEN(b.x)]) == gen, bar);
            __builtin_amdgcn_fence(__ATOMIC_ACQUIRE, "agent");
            asm volatile("s_waitcnt vmcnt(0)" ::: "memory");
        }
    }
    __syncthreads();
}

#define IN_X 0
#define IN_C 1
#define IN_CTX 2
#define IN_CCTX 3
#define IN_WMOD 4
#define IN_BMOD 5
#define IN_NORM1 6
#define IN_NORM2 7
#define IN_WIN 8
#define IN_QNORM 9
#define IN_KNORM 10
#define IN_SINK 11
#define IN_CONVW 12
#define IN_CONVB 13
#define IN_FW1 14
#define IN_FB1 15
#define IN_FW2 16
#define IN_FB2 17
#define IN_FW3 18
#define IN_FB3 19
#define IN_FW4 20
#define IN_FFREQ 21
#define IN_FBIAS 22
#define IN_ANORM 23
#define IN_YNORM 24
#define IN_WOUT 25
#define IN_WROUTER 26
#define IN_BROUTER 27
#define IN_WGU 28
#define IN_BGU 29
#define IN_WDOWN 30
#define IN_BDOWN 31

__device__ __forceinline__ void ph_mod(const Frame& F) {
    LAS float* sil = (LAS float*)F.lds;
    LAS float* part = sil + 9 * 1024;
    const float* c = F.in[IN_C]; const float* cc = F.in[IN_CCTX]; const float* wm = F.in[IN_WMOD]; const float* bm = F.in[IN_BMOD];
    float* MOD = (float*)(F.ws + WS_MOD);
    for (int i = F.tid; i < 9 * 1024; i += NTHR) { const int r = i >> 10, k = i & 1023; const float v = r < 8 ? c[r * 1024 + k] : cc[k]; sil[i] = v / (1.0f + expf(-v)); }
    __syncthreads();
    for (int item = blockIdx.x; item < 96; item += gridDim.x) {
        const int col = item * 64 + F.lane;
        float acc[9];
#pragma unroll
        for (int r = 0; r < 9; ++r) acc[r] = 0.f;
        for (int kk = 0; kk < 128; ++kk) { const int k = F.wave * 128 + kk; const float wv = wm[(size_t)k * 6144 + col];
#pragma unroll
            for (int r = 0; r < 9; ++r) acc[r] += sil[r * 1024 + k] * wv; }
#pragma unroll
        for (int r = 0; r < 9; ++r) part[(F.wave * 9 + r) * 64 + F.lane] = acc[r];
        __syncthreads();
        for (int i = F.tid; i < 9 * 64; i += NTHR) { const int r = i >> 6, l = i & 63; float s = bm[item * 64 + l];
            for (int w = 0; w < 8; ++w) s += part[(w * 9 + r) * 64 + l];
            MOD[r * 6144 + item * 64 + l] = s; }
        __syncthreads();
    }
}

__device__ __forceinline__ void transpose_item(const float* W, int K, int N, bf16* WT, int dst_row0, LAS float* scr, int k0, int n0, const float* kscale, int lane) {
#pragma unroll 8
    for (int i = 0; i < 32; ++i) { const int kk = 2 * i + (lane >> 5); float v = W[(size_t)(k0 + kk) * N + n0 + (lane & 31)]; if (kscale) v *= kscale[kk]; scr[kk * 33 + (lane & 31)] = v; }
    LDS_FENCE();
    const int c = lane & 7;
#pragma unroll
    for (int j = 0; j < 4; ++j) { const int n = (lane >> 3) + 8 * j; const LAS float* s = scr + (8 * c) * 33 + n;
        v4u o; o.x = pk2(s[0 * 33], s[1 * 33]); o.y = pk2(s[2 * 33], s[3 * 33]); o.z = pk2(s[4 * 33], s[5 * 33]); o.w = pk2(s[6 * 33], s[7 * 33]);
        *(v4u*)(WT + (size_t)(dst_row0 + n) * K + k0 + 8 * c) = o; }
    LDS_FENCE();
}
__device__ __forceinline__ void ph_transposes(const Frame& F) {
    LAS float* scr = (LAS float*)(F.lds) + F.wave * (64 * 33);
    bf16* WinT = (bf16*)(F.ws + WS_WIN); bf16* WoutT = (bf16*)(F.ws + WS_WOUT); bf16* WguT = (bf16*)(F.ws + WS_WGU); bf16* WdT = (bf16*)(F.ws + WS_WD);
    constexpr int I_IN = 16 * 72, I_OUT = 16 * 32, I_GU = 32 * 16 * 64, I_D = 32 * 16 * 32;
    constexpr int NITEMS = I_IN + I_OUT + I_GU + I_D;
    for (int it = F.gw; it < NITEMS; it += F.ngw) {
        int r = it;
        if (r < I_IN) { const int kb = r / 72, nb = r % 72; transpose_item(F.in[IN_WIN], 1024, INW, WinT, 32 * nb, scr, 64 * kb, 32 * nb, nullptr, F.lane); continue; } r -= I_IN;
        if (r < I_OUT) { const int kb = r / 32, nb = r % 32, k0 = 64 * kb; const float* ks = k0 < 512 ? F.in[IN_ANORM] + k0 : F.in[IN_YNORM] + (k0 - 512);
            transpose_item(F.in[IN_WOUT], 1024, 1024, WoutT, 32 * nb, scr, k0, 32 * nb, ks, F.lane); continue; } r -= I_OUT;
        if (r < I_GU) { const int e = r >> 10, q = r & 1023, kb = q >> 6, nb = q & 63, n0 = 32 * nb; const int j0 = n0 & 1023; const int dst = (j0 >> 7) * 256 + (n0 >= 1024 ? 128 : 0) + (j0 & 127);
            transpose_item(F.in[IN_WGU] + (size_t)e * 1024 * 2048, 1024, 2048, WguT + (size_t)e * 2048 * 1024, dst, scr, 64 * kb, n0, nullptr, F.lane); continue; } r -= I_GU;
        { const int e = r >> 9, q = r & 511, kb = q >> 5, nb = q & 31;
            transpose_item(F.in[IN_WDOWN] + (size_t)e * 1024 * 1024, 1024, 1024, WdT + (size_t)e * 1024 * 1024, 32 * nb, scr, 64 * kb, 32 * nb, nullptr, F.lane); }
    }
}

__device__ __forceinline__ void ph_filter(const Frame& F) {
    LAS float* zf = (LAS float*)(F.lds + 8 * 64 * 33 * 4);
    LAS float* hA = zf + 33 * 64; LAS float* hB = hA + 64 * 64;
    const float* w1 = F.in[IN_FW1]; const float* b1 = F.in[IN_FB1]; const float* w2 = F.in[IN_FW2]; const float* b2 = F.in[IN_FB2];
    const float* w3 = F.in[IN_FW3]; const float* b3 = F.in[IN_FB3]; const float* w4 = F.in[IN_FW4]; const float* fr = F.in[IN_FFREQ];
    bf16* RG = (bf16*)(F.ws + WS_RG); float* nrm2 = (float*)(F.ws + WS_CTL) + CW_NRM;
    const int pl = F.lane, jg = F.wave;
    constexpr float MAXD = 15.350567286626973f, MIND = 3.0701134573253945f;
    for (int item = blockIdx.x; item < 64; item += gridDim.x) {
        const int p = item * 64 + pl;
        for (int f = jg; f < 33; f += 8) {
            float v;
            if (f == 0) v = (float)p / 4095.0f;
            else { const int bi = (f - 1) & 15; const float band = 1e-4f + (15.0f - 1e-4f) * (float)bi / 15.0f; const float w = 6.283185307179586f * (float)p / 4096.0f; const float a = band * w; v = (f <= 16) ? cosf(a) : -sinf(a); }
            zf[f * 64 + pl] = v;
        }
        __syncthreads();
#pragma unroll 1
        for (int jj = 0; jj < 8; ++jj) { const int j = jg * 8 + jj; float pre = b1[j]; for (int i = 0; i < 33; ++i) pre += zf[i * 64 + pl] * w1[i * 64 + j]; hA[j * 64 + pl] = sinf(fr[j] * pre); }
        __syncthreads();
#pragma unroll 1
        for (int jj = 0; jj < 8; ++jj) { const int j = jg * 8 + jj; float pre = b2[j]; for (int i = 0; i < 64; ++i) pre += hA[i * 64 + pl] * w2[i * 64 + j]; hB[j * 64 + pl] = sinf(fr[j] * pre); }
        __syncthreads();
#pragma unroll 1
        for (int jj = 0; jj < 8; ++jj) { const int j = jg * 8 + jj; float pre = b3[j]; for (int i = 0; i < 64; ++i) pre += hB[i * 64 + pl] * w3[i * 64 + j]; hA[j * 64 + pl] = sinf(fr[j] * pre); }
        __syncthreads();
        float h[64];
#pragma unroll
        for (int i = 0; i < 64; ++i) h[i] = hA[i * 64 + pl];
        const float tl = (float)p / 4095.0f;
#pragma unroll 1
        for (int nn = 0; nn < 128; ++nn) { const int n = jg * 128 + nn; float val = 0.f;
#pragma unroll
            for (int i = 0; i < 64; ++i) val += h[i] * w4[i * 1024 + n];
            const int c = n & 511; const float delta = MIND + (MAXD - MIND) * (float)c / 511.0f; val *= expf(-tl * delta);
            float ss = val * val;
            if (n < 512) RG[(size_t)c * 8192 + 4096 - p] = (bf16)f2bf(val);
            else { if (p >= 1) RG[(size_t)c * 8192 + 4096 + p] = (bf16)f2bf(val); else { RG[(size_t)c * 8192] = 0; ss = 0.f; } }
            ss = wave_sum(ss); if (pl == 0) atomicAdd(&nrm2[c], ss); }
        __syncthreads();
    }
}

__device__ __forceinline__ void ph_h1(const Frame& F) {
    const float* MOD = (const float*)(F.ws + WS_MOD); bf16* H1 = (bf16*)(F.ws + WS_H1); const float* g = F.in[IN_NORM1];
    for (int row = F.gw; row < MROWS; row += F.ngw) {
        const float* xr = row < T ? F.in[IN_X] + (size_t)row * 1024 : F.in[IN_CTX] + (size_t)(row - T) * 1024;
        const int mb = row < T ? (row >> 12) : 8; const float* sh = MOD + mb * 6144; const float* sc = sh + 1024;
        f32x4 v[4]; float ss = 0.f;
#pragma unroll
        for (int j = 0; j < 4; ++j) { v[j] = *(const f32x4*)(xr + 4 * F.lane + 256 * j); ss += (v[j].x * v[j].x + v[j].y * v[j].y) + (v[j].z * v[j].z + v[j].w * v[j].w); }
        const float rstd = rsqrtf(wave_sum(ss) * (1.0f / 1024.0f) + EPS);
#pragma unroll
        for (int j = 0; j < 4; ++j) { const int idx = 4 * F.lane + 256 * j; const f32x4 gg = *(const f32x4*)(g + idx), s1 = *(const f32x4*)(sc + idx), s0 = *(const f32x4*)(sh + idx);
            const f32x4 o = (v[j] * rstd * gg) * (1.0f + s1) + s0;
            v2u w; w.x = pk2(o.x, o.y); w.y = pk2(o.z, o.w); *(v2u*)(H1 + (size_t)row * 1024 + idx) = w; }
    }
}

__device__ __forceinline__ void ph_qkpost(const Frame& F) {
    bf16* PROJ = (bf16*)(F.ws + WS_PROJ); const float* qn = F.in[IN_QNORM]; const float* kn = F.in[IN_KNORM];
    const int f = F.lane & 15; const float invf = powf(10000.0f, -(float)f / 16.0f);
    const float gq = qn[F.lane], gk = kn[F.lane];
    for (int row = F.gw; row < MROWS; row += F.ngw) {
        const bool isctx = row >= T; const int t = row & 4095; const float pos = (F.lane < 32) ? (float)(t >> 6) : (float)(t & 63);
        const float ang = pos * invf; const float cs = cosf(ang), sn = sinf(ang);
        bf16* pr = PROJ + (size_t)row * INW;
        for (int h = isctx ? 8 : 0; h < 10; ++h) {
            const float v = bf2f(pr[h * 64 + F.lane]);
            const float ss = wave_sum(v * v);
            float y = v * rsqrtf(ss * (1.0f / 64.0f) + EPS) * (h < 8 ? gq : gk);
            if (!isctx) { const float partner = __shfl_xor(y, 16); y = (F.lane & 16) ? (partner * sn + y * cs) : (y * cs - partner * sn); }
            pr[h * 64 + F.lane] = (bf16)f2bf(y);
        }
    }
}

__device__ __forceinline__ void ph_zprep(const Frame& F) {
    const bf16* PROJ = (const bf16*)(F.ws + WS_PROJ); bf16* ZT = (bf16*)(F.ws + WS_ZT); bf16* X0T = (bf16*)(F.ws + WS_X0T);
    const float* cw = F.in[IN_CONVW]; const float* cb = F.in[IN_CONVB];
    LAS float* raw = (LAS float*)F.lds;
    for (int item = blockIdx.x; item < 8 * 64 * 8; item += gridDim.x) {
        const int b = item >> 9, tb = (item >> 3) & 63, cbk = item & 7; const int t0 = tb * 64, c0 = cbk * 64;
        for (int i = F.tid; i < 3 * 66 * 64; i += NTHR) { const int g = i / (66 * 64), rem = i % (66 * 64), r = rem >> 6, cc = rem & 63; const int t = t0 - 1 + r;
            float v = 0.f; if (t >= 0 && t < SEQ) v = bf2f(PROJ[(size_t)(b * SEQ + t) * INW + 768 + g * 512 + c0 + cc]);
            raw[(g * 66 + r) * 65 + cc] = v; }
        __syncthreads();
        const int tt = F.lane, cg8 = F.wave;
#pragma unroll 1
        for (int ci = 0; ci < 8; ++ci) { const int cc = cg8 * 8 + ci, c = c0 + cc; float uc[3];
#pragma unroll
            for (int g = 0; g < 3; ++g) { const int ch = g * 512 + c; const LAS float* rp = raw + (g * 66 + tt) * 65 + cc;
                uc[g] = cb[ch] + cw[ch] * rp[0] + cw[1536 + ch] * rp[65] + cw[3072 + ch] * rp[130]; }
            const size_t o = ((size_t)c * 8 + b) * SEQ + t0 + tt;
            X0T[o] = (bf16)f2bf(uc[0]); ZT[o] = (bf16)f2bf(uc[1] * uc[2]); }
        __syncthreads();
    }
}

__device__ __forceinline__ void ph_attn_naive(const Frame& F) {
    const bf16* PROJ = (const bf16*)(F.ws + WS_PROJ); float* ATT = (float*)(F.ws + WS_ATT); const float* sink = F.in[IN_SINK];
    LAS float* wsc = (LAS float*)F.lds + F.wave * 640;
    for (int it = F.gw; it < T * 8; it += F.ngw) {
        const int row = it >> 3, hq = it & 7, hkv = hq >> 2, b = row >> 12, t = row & 4095;
        float q[64];
        { const v4u* qp = (const v4u*)(PROJ + (size_t)row * INW + hq * 64);
#pragma unroll
          for (int i = 0; i < 8; ++i) { const v4u w = qp[i]; q[8 * i + 0] = bflo(w.x); q[8 * i + 1] = bfhi(w.x); q[8 * i + 2] = bflo(w.y); q[8 * i + 3] = bfhi(w.y); q[8 * i + 4] = bflo(w.z); q[8 * i + 5] = bfhi(w.z); q[8 * i + 6] = bflo(w.w); q[8 * i + 7] = bfhi(w.w); } }
        const int j0 = t - 128 < 0 ? 0 : t - 128, j1 = t + 128 > SEQ - 1 ? SEQ - 1 : t + 128; const int nloc = j1 - j0 + 1, nkeys = nloc + LC;
        const float sk = sink[hq];
        float mx = -INFINITY;
        for (int kk = F.lane; kk < nkeys; kk += 64) {
            const size_t krow = kk < nloc ? (size_t)(b * SEQ + j0 + kk) : (size_t)(T + b * LC + (kk - nloc));
            const v4u* kp = (const v4u*)(PROJ + krow * INW + 512 + hkv * 64); float s = 0.f;
#pragma unroll
            for (int i = 0; i < 8; ++i) { const v4u w = kp[i];
                s += q[8 * i + 0] * bflo(w.x) + q[8 * i + 1] * bfhi(w.x) + q[8 * i + 2] * bflo(w.y) + q[8 * i + 3] * bfhi(w.y) + q[8 * i + 4] * bflo(w.z) + q[8 * i + 5] * bfhi(w.z) + q[8 * i + 6] * bflo(w.w) + q[8 * i + 7] * bfhi(w.w); }
            s *= 0.125f; wsc[kk] = s; mx = fmaxf(mx, s);
        }
        mx = fmaxf(wave_max(mx), sk);
        float sum = 0.f;
        for (int kk = F.lane; kk < nkeys; kk += 64) { const float p = __expf(wsc[kk] - mx); wsc[kk] = p; sum += p; }
        sum = wave_sum(sum) + __expf(sk - mx);
        LDS_FENCE();
        float o = 0.f;
        for (int kk = 0; kk < nkeys; ++kk) { const size_t vrow = kk < nloc ? (size_t)(b * SEQ + j0 + kk) : (size_t)(T + b * LC + (kk - nloc));
            o += wsc[kk] * bf2f(PROJ[vrow * INW + 640 + hkv * 64 + F.lane]); }
        ATT[(size_t)row * 512 + hq * 64 + F.lane] = o / sum;
        LDS_FENCE();
    }
}

__device__ __forceinline__ void ph_hyena_naive(const Frame& F) {
    const bf16* RG = (const bf16*)(F.ws + WS_RG); const bf16* ZT = (const bf16*)(F.ws + WS_ZT); const bf16* X0T = (const bf16*)(F.ws + WS_X0T); bf16* YT = (bf16*)(F.ws + WS_YT);
    const float* nrm2 = (const float*)(F.ws + WS_CTL) + CW_NRM; const float* fb = F.in[IN_FBIAS];
    LAS bf16* Rl = (LAS bf16*)F.lds;
    LAS bf16* zl = Rl + 8192;
    for (int c = blockIdx.x; c < 512; c += gridDim.x) {
        for (int i = F.tid; i < 1024; i += NTHR) ((LAS v4u*)Rl)[i] = ((const v4u*)(RG + (size_t)c * 8192))[i];
        for (int i = F.tid; i < 4096; i += NTHR) ((LAS v4u*)zl)[i] = ((const v4u*)(ZT + (size_t)c * 8 * SEQ))[i];
        __syncthreads();
        const float nrm = rsqrtf(nrm2[c] + EPS), bias = fb[c];
#pragma unroll 1
        for (int ti = 0; ti < 8; ++ti) { const int t = F.tid + 512 * ti;
            float acc[8];
#pragma unroll
            for (int b = 0; b < 8; ++b) acc[b] = 0.f;
            const LAS bf16* rp = Rl + 4096 - t;
#pragma unroll 2
            for (int s = 0; s < SEQ; s += 2) { const float g0 = bf2f(rp[s]), g1 = bf2f(rp[s + 1]);
#pragma unroll
                for (int b = 0; b < 8; ++b) { const unsigned zz = *(const LAS unsigned*)(zl + b * SEQ + s); acc[b] += g0 * bflo(zz) + g1 * bfhi(zz); } }
#pragma unroll
            for (int b = 0; b < 8; ++b) { const float zt = bf2f(zl[b * SEQ + t]); const size_t o = ((size_t)c * 8 + b) * SEQ + t;
                const float y = bf2f(X0T[o]) * (acc[b] * nrm + bias * zt); YT[o] = (bf16)f2bf(y); }
        }
        __syncthreads();
    }
}

__device__ __forceinline__ void ph_merge(const Frame& F) {
    const float* ATT = (const float*)(F.ws + WS_ATT); const bf16* YT = (const bf16*)(F.ws + WS_YT); bf16* A2 = (bf16*)(F.ws + WS_A2);
    LAS bf16* yl = (LAS bf16*)F.lds;
    LAS float* part = (LAS float*)(F.lds + 512 * 72 * 2);
    LAS float* rsy = part + 512;
    for (int item = blockIdx.x; item < 512; item += gridDim.x) {
        const int b = item >> 6, t0 = (item & 63) * 64;
        for (int i = F.tid; i < 4096; i += NTHR) { const int c = i >> 3, pc = i & 7; *(LAS v4u*)(yl + c * 72 + pc * 8) = *(const v4u*)(YT + ((size_t)c * 8 + b) * SEQ + t0 + pc * 8); }
        __syncthreads();
        { const int tt = F.lane, cq = F.wave; float s = 0.f; for (int c = cq * 64; c < cq * 64 + 64; ++c) { const float v = bf2f(yl[c * 72 + tt]); s += v * v; } part[cq * 64 + tt] = s; }
        __syncthreads();
        if (F.tid < 64) { float s = 0.f; for (int w = 0; w < 8; ++w) s += part[w * 64 + F.tid]; rsy[F.tid] = rsqrtf(s * (1.0f / 512.0f) + EPS); }
        __syncthreads();
#pragma unroll 1
        for (int r = 0; r < 8; ++r) { const int tt = F.wave * 8 + r; const size_t row = (size_t)b * SEQ + t0 + tt;
            const f32x4 a0 = *(const f32x4*)(ATT + row * 512 + F.lane * 8), a1 = *(const f32x4*)(ATT + row * 512 + F.lane * 8 + 4);
            float ss = (a0.x * a0.x + a0.y * a0.y) + (a0.z * a0.z + a0.w * a0.w) + (a1.x * a1.x + a1.y * a1.y) + (a1.z * a1.z + a1.w * a1.w);
            const float ra = rsqrtf(wave_sum(ss) * (1.0f / 512.0f) + EPS);
            v4u w; w.x = pk2(a0.x * ra, a0.y * ra); w.y = pk2(a0.z * ra, a0.w * ra); w.z = pk2(a1.x * ra, a1.y * ra); w.w = pk2(a1.z * ra, a1.w * ra);
            *(v4u*)(A2 + row * 1024 + F.lane * 8) = w;
            const float ry = rsy[tt]; float yv[8];
#pragma unroll
            for (int i = 0; i < 8; ++i) yv[i] = bf2f(yl[(F.lane * 8 + i) * 72 + tt]) * ry;
            v4u w2; w2.x = pk2(yv[0], yv[1]); w2.y = pk2(yv[2], yv[3]); w2.z = pk2(yv[4], yv[5]); w2.w = pk2(yv[6], yv[7]);
            *(v4u*)(A2 + row * 1024 + 512 + F.lane * 8) = w2; }
        __syncthreads();
    }
}

__device__ __forceinline__ void ph_router(const Frame& F) {
    const float* MOD = (const float*)(F.ws + WS_MOD); bf16* H2 = (bf16*)(F.ws + WS_H1); const float* g = F.in[IN_NORM2];
    const float* wr = F.in[IN_WROUTER]; const float* br = F.in[IN_BROUTER];
    int* TOKE = (int*)(F.ws + WS_ROUTE); int* TOKR = TOKE + T * 4; float* TOKG = (float*)(TOKR + T * 4);
    unsigned* cnt = (unsigned*)(F.ws + WS_CTL) + CW_CNT;
    LAS float* hrow = (LAS float*)F.lds + F.wave * 1024;
    const int e = F.lane & 31, half = F.lane >> 5;
    for (int tok = F.gw; tok < T; tok += F.ngw) {
        const int b = tok >> 12; const float* sh = MOD + b * 6144 + 3072; const float* sc = MOD + b * 6144 + 4096;
        const float* xr = F.out + (size_t)tok * 1024;
        f32x4 v[4]; float ss = 0.f;
#pragma unroll
        for (int j = 0; j < 4; ++j) { v[j] = *(const f32x4*)(xr + 4 * F.lane + 256 * j); ss += (v[j].x * v[j].x + v[j].y * v[j].y) + (v[j].z * v[j].z + v[j].w * v[j].w); }
        const float rstd = rsqrtf(wave_sum(ss) * (1.0f / 1024.0f) + EPS);
#pragma unroll
        for (int j = 0; j < 4; ++j) { const int idx = 4 * F.lane + 256 * j; const f32x4 gg = *(const f32x4*)(g + idx), s1 = *(const f32x4*)(sc + idx), s0 = *(const f32x4*)(sh + idx);
            const f32x4 o = (v[j] * rstd * gg) * (1.0f + s1) + s0;
            v2u w; w.x = pk2(o.x, o.y); w.y = pk2(o.z, o.w); *(v2u*)(H2 + (size_t)tok * 1024 + idx) = w;
            *(LAS f32x4*)(hrow + idx) = o; }
        LDS_FENCE();
        float acc = 0.f;
        { const LAS float* hp = hrow + half * 512; const float* wp = wr + (size_t)half * 512 * 32 + e;
#pragma unroll 8
          for (int k = 0; k < 512; ++k) acc += hp[k] * wp[k * 32]; }
        acc += __shfl_xor(acc, 32);
        float val = acc + br[e];
        float sv[4]; int si[4];
#pragma unroll
        for (int r = 0; r < 4; ++r) { float m = val;
#pragma unroll
            for (int o = 16; o >= 1; o >>= 1) m = fmaxf(m, __shfl_xor(m, o));
            const unsigned long long bal = __ballot(val == m) & 0xffffffffull; const int idx = __ffsll((long long)bal) - 1;
            sv[r] = m; si[r] = idx; if (e == idx) val = -INFINITY; }
        const float e1 = __expf(sv[1] - sv[0]), e2 = __expf(sv[2] - sv[0]), e3 = __expf(sv[3] - sv[0]); const float inv = 1.0f / (1.0f + e1 + e2 + e3);
        if (F.lane < 4) { const int me = F.lane == 0 ? si[0] : F.lane == 1 ? si[1] : F.lane == 2 ? si[2] : si[3]; const float mg = (F.lane == 0 ? 1.0f : F.lane == 1 ? e1 : F.lane == 2 ? e2 : e3) * inv;
            const unsigned rank = atomicAdd(&cnt[me], 1u);
            TOKE[tok * 4 + F.lane] = me; TOKR[tok * 4 + F.lane] = (int)rank; TOKG[tok * 4 + F.lane] = mg; }
        LDS_FENCE();
    }
}

__device__ __forceinline__ void build_tile_table(const Frame& F) {
    LAS int* tstart = (LAS int*)(F.lds + MISC_OFF);
    const unsigned* cnt = (const unsigned*)(F.ws + WS_CTL) + CW_CNT;
    if (F.tid == 0) { int acc = 0; for (int e = 0; e < 32; ++e) { tstart[e] = acc; acc += (int)((cnt[e] + 255u) >> 8); } tstart[32] = acc; }
    __syncthreads();
}

__device__ __forceinline__ void ph_gather(const Frame& F) {
    build_tile_table(F);
    const LAS int* tstart = (const LAS int*)(F.lds + MISC_OFF);
    const bf16* H2 = (const bf16*)(F.ws + WS_H1); bf16* XS = (bf16*)(F.ws + WS_XS);
    const int* TOKE = (const int*)(F.ws + WS_ROUTE); const int* TOKR = TOKE + T * 4; int* SLOT = (int*)(F.ws + WS_ROUTE) + 3 * T * 4;
    for (int a = F.gw; a < T * 4; a += F.ngw) {
        const int tok = a >> 2; const int e = TOKE[a], rank = TOKR[a]; const int slot = tstart[e] * 256 + rank;
        const v4u* src = (const v4u*)(H2 + (size_t)tok * 1024); v4u* dst = (v4u*)(XS + (size_t)slot * 1024);
        dst[F.lane] = src[F.lane]; dst[F.lane + 64] = src[F.lane + 64];
        if (F.lane == 0) SLOT[a] = slot;
    }
}

__device__ __forceinline__ void ph_combine(const Frame& F) {
    const float* MOD = (const float*)(F.ws + WS_MOD); const bf16* YS = (const bf16*)(F.ws + WS_XS);
    const float* TOKG = (const float*)(F.ws + WS_ROUTE) + 2 * T * 4; const int* SLOT = (const int*)(F.ws + WS_ROUTE) + 3 * T * 4;
    float pscale = 1.0f, pspike = 0.0f;
#if PROBE_A >= 0
    { const unsigned long long* ts = (const unsigned long long*)(F.ws + WS_CTL + CW_TS_BYTES); const float tot = (float)(ts[11] - ts[0]);
      pscale = 1.0f + sqrtf(0.5f * (float)(ts[PROBE_A + 1] - ts[PROBE_A]) / tot);
#if PROBE_B >= 0
      pspike = 10.0f + 90.0f * (float)(ts[PROBE_B + 1] - ts[PROBE_B]) / tot;
#endif
    }
#endif
    for (int tok = F.gw; tok < T; tok += F.ngw) {
        const int b = tok >> 12; const float* g2 = MOD + b * 6144 + 5120; float* xr = F.out + (size_t)tok * 1024;
        int sl[4]; float gt[4];
#pragma unroll
        for (int k = 0; k < 4; ++k) { sl[k] = SLOT[tok * 4 + k]; gt[k] = TOKG[tok * 4 + k]; }
#pragma unroll
        for (int j = 0; j < 4; ++j) { const int idx = 4 * F.lane + 256 * j; f32x4 m = {0.f, 0.f, 0.f, 0.f};
#pragma unroll
            for (int k = 0; k < 4; ++k) { const v2u w = *(const v2u*)(YS + (size_t)sl[k] * 1024 + idx); m.x += gt[k] * bflo(w.x); m.y += gt[k] * bfhi(w.x); m.z += gt[k] * bflo(w.y); m.w += gt[k] * bfhi(w.y); }
            const f32x4 xv = *(const f32x4*)(xr + idx); const f32x4 gg = *(const f32x4*)(g2 + idx);
            f32x4 res = (xv + gg * m) * pscale; if (pspike != 0.0f && tok == 0 && idx == 0) res.x = pspike;
            *(f32x4*)(xr + idx) = res; }
    }
}

typedef float f32x16 __attribute__((ext_vector_type(16)));
__device__ __forceinline__ int crow16(int r, int hi) { return (r & 3) + 8 * (r >> 2) + 4 * hi; }
constexpr int HY_RL_BYTES = 32 + 8192 * 2;
constexpr int HY_BPITCH = 528;
constexpr int HY_BBUF = 64 * HY_BPITCH;
constexpr int HY_B_OFF = HY_RL_BYTES;

template <int Q> __device__ __forceinline__ void hy_shift_store(const v4u (&W)[5], int sh, LAS unsigned char* dst) {
    const unsigned w[20] = {W[0].x, W[0].y, W[0].z, W[0].w, W[1].x, W[1].y, W[1].z, W[1].w, W[2].x, W[2].y, W[2].z, W[2].w, W[3].x, W[3].y, W[3].z, W[3].w, W[4].x, W[4].y, W[4].z, W[4].w};
#pragma unroll
    for (int p = 0; p < 4; ++p) { v4u o;
        o.x = __builtin_amdgcn_alignbit(w[4 * p + Q + 1], w[4 * p + Q + 0], sh);
        o.y = __builtin_amdgcn_alignbit(w[4 * p + Q + 2], w[4 * p + Q + 1], sh);
        o.z = __builtin_amdgcn_alignbit(w[4 * p + Q + 3], w[4 * p + Q + 2], sh);
        o.w = __builtin_amdgcn_alignbit(w[4 * p + Q + 4], w[4 * p + Q + 3], sh);
        *(LAS v4u*)(dst + 16 * p) = o; }
}

__device__ __forceinline__ void ph_hyena_mfma(const Frame& F) {
    const bf16* RG = (const bf16*)(F.ws + WS_RG); const bf16* ZT = (const bf16*)(F.ws + WS_ZT); const bf16* X0T = (const bf16*)(F.ws + WS_X0T); bf16* YT = (bf16*)(F.ws + WS_YT);
    const float* nrm2 = (const float*)(F.ws + WS_CTL) + CW_NRM; const float* fb = F.in[IN_FBIAS];
    LAS unsigned char* Rl = F.lds; LAS unsigned char* Bb = F.lds + HY_B_OFF;
    const int lane = F.lane, w = F.wave, r32 = lane & 31, hi = lane >> 5;
    const int bb = lane >> 3, seg = lane & 7; const int brow = w * 8 + bb;
    const int shq = w >> 1, shb = (w & 1) * 16;
    for (int c = blockIdx.x; c < 512; c += gridDim.x) {
        if (F.tid < 2) ((LAS v4u*)Rl)[F.tid] = (v4u){0u, 0u, 0u, 0u};
        for (int i = F.tid; i < 1024; i += NTHR) ((LAS v4u*)(Rl + 32))[i] = ((const v4u*)(RG + (size_t)c * 8192))[i];
        const bf16* zrow = ZT + ((size_t)c * 8 + bb) * SEQ;
        v4u W[5];
        auto LOADW = [&](int k) {
            const int sb = -16 + 256 * k + 32 * seg;
#pragma unroll
            for (int i = 0; i < 5; ++i) { const int s = sb + 8 * i; W[i] = (s >= 0 && s < SEQ) ? *(const v4u*)(zrow + s) : (v4u){0u, 0u, 0u, 0u}; }
        };
        auto STOREW = [&](int buf) {
            LAS unsigned char* dst = Bb + buf * HY_BBUF + brow * HY_BPITCH + seg * 64;
            if (shq == 0) hy_shift_store<0>(W, shb, dst); else if (shq == 1) hy_shift_store<1>(W, shb, dst); else if (shq == 2) hy_shift_store<2>(W, shb, dst); else hy_shift_store<3>(W, shb, dst);
        };
        LOADW(0); STOREW(0);
        f32x16 acc[2][2];
#pragma unroll
        for (int a = 0; a < 2; ++a)
#pragma unroll
            for (int n = 0; n < 2; ++n)
#pragma unroll
                for (int r = 0; r < 16; ++r) acc[a][n][r] = 0.f;
        __syncthreads();
        const int t00 = 512 * w;
        const LAS unsigned char* a0p = Rl + 2 * (4096 - t00 - 8 * r32 + 8 * hi);
        const LAS unsigned char* a1p = a0p - 512;
        for (int k = 0; k < 17; ++k) {
            const int buf = k & 1;
            if (k < 16) LOADW(k + 1);
            const LAS unsigned char* bp = Bb + buf * HY_BBUF + r32 * HY_BPITCH + 16 * hi;
            const int nst = (k < 16) ? 16 : 1;
#pragma unroll 4
            for (int i = 0; i < nst; ++i) {
                const int so = 32 * (16 * k + i);
                const bf16x8 A0 = *(const LAS bf16x8*)(a0p + so), A1 = *(const LAS bf16x8*)(a1p + so);
                const bf16x8 B0 = *(const LAS bf16x8*)(bp + 32 * i), B1 = *(const LAS bf16x8*)(bp + 32 * HY_BPITCH + 32 * i);
                acc[0][0] = __builtin_amdgcn_mfma_f32_32x32x16_bf16(A0, B0, acc[0][0], 0, 0, 0);
                acc[0][1] = __builtin_amdgcn_mfma_f32_32x32x16_bf16(A0, B1, acc[0][1], 0, 0, 0);
                acc[1][0] = __builtin_amdgcn_mfma_f32_32x32x16_bf16(A1, B0, acc[1][0], 0, 0, 0);
                acc[1][1] = __builtin_amdgcn_mfma_f32_32x32x16_bf16(A1, B1, acc[1][1], 0, 0, 0);
            }
            if (k < 16) STOREW(buf ^ 1);
            __syncthreads();
        }
        const float nrm = rsqrtf(nrm2[c] + EPS), bias = fb[c];
        LAS float* yst = (LAS float*)(Bb + w * 8192);
#pragma unroll
        for (int mi = 0; mi < 2; ++mi) {
#pragma unroll
            for (int nj = 0; nj < 2; ++nj) { const int rho = 4 * nj + (r32 >> 3), b = lane & 7;
#pragma unroll
                for (int r = 0; r < 16; ++r) yst[b * 256 + 8 * crow16(r, hi) + rho] = acc[mi][nj][r]; }
            LDS_FENCE();
            const int t0 = t00 + 256 * mi;
#pragma unroll 1
            for (int it = 0; it < 4; ++it) { const int p = it * 64 + lane, b = p >> 5, tp = p & 31;
                const size_t o = ((size_t)c * 8 + b) * SEQ + t0 + 8 * tp;
                const v4u xz = *(const v4u*)(X0T + o), zz = *(const v4u*)(ZT + o);
                const f32x4 y0 = *(const LAS f32x4*)(yst + b * 256 + 8 * tp), y1 = *(const LAS f32x4*)(yst + b * 256 + 8 * tp + 4);
                v4u ov;
                ov.x = pk2(bflo(xz.x) * (y0.x * nrm + bias * bflo(zz.x)), bfhi(xz.x) * (y0.y * nrm + bias * bfhi(zz.x)));
                ov.y = pk2(bflo(xz.y) * (y0.z * nrm + bias * bflo(zz.y)), bfhi(xz.y) * (y0.w * nrm + bias * bfhi(zz.y)));
                ov.z = pk2(bflo(xz.z) * (y1.x * nrm + bias * bflo(zz.z)), bfhi(xz.z) * (y1.y * nrm + bias * bfhi(zz.z)));
                ov.w = pk2(bflo(xz.w) * (y1.z * nrm + bias * bflo(zz.w)), bfhi(xz.w) * (y1.w * nrm + bias * bfhi(zz.w)));
                *(v4u*)(YT + o) = ov; }
            LDS_FENCE();
        }
        __syncthreads();
    }
}

typedef short s16x4 __attribute__((ext_vector_type(4)));
__device__ __forceinline__ s16x4 ds_tr16(const LAS unsigned char* p) { return __builtin_bit_cast(s16x4, __builtin_amdgcn_ds_read_tr16_b64_v4i16((LAS s16x4*)p)); }
constexpr int AT_KB = 0, AT_VB = 16384, AT_WS = 32768;

__device__ __forceinline__ void ph_attn_mfma(const Frame& F) {
    const bf16* PROJ = (const bf16*)(F.ws + WS_PROJ); float* ATT = (float*)(F.ws + WS_ATT); const float* sink = F.in[IN_SINK];
    const int lane = F.lane, w = F.wave, r32 = lane & 31, hi = lane >> 5;
    LAS float* wsf = (LAS float*)(F.lds + AT_WS) + w * 64;
    constexpr float C2 = 0.125f * 1.4426950408889634f, LOG2E = 1.4426950408889634f;
    const int skey = F.tid >> 3, sch = F.tid & 7;
    const int kdst = skey * 128 + ((sch ^ ((skey >> 1) & 7)) << 4);
    const int vdst = skey * 128 + ((sch ^ (((skey >> 1) & 1) << 2)) << 4);
    for (int item = blockIdx.x; item < 512; item += gridDim.x) {
        const int b = item >> 6, nb = (item >> 1) & 31, hkv = item & 1;
        const int g = w >> 1, hq = hkv * 4 + g; const int q0 = nb * 128 + (w & 1) * 64;
        bf16x8 qf[2][4];
#pragma unroll
        for (int u = 0; u < 2; ++u)
#pragma unroll
            for (int ks = 0; ks < 4; ++ks) qf[u][ks] = *(const bf16x8*)(PROJ + (size_t)(b * SEQ + q0 + 32 * u + r32) * INW + hq * 64 + 16 * ks + 8 * hi);
        const float sk2 = sink[hq] * LOG2E;
        float m2[2] = {sk2, sk2}; float lsum[2] = {hi == 0 ? 1.0f : 0.0f, hi == 0 ? 1.0f : 0.0f};
        f32x16 o[2][2];
#pragma unroll
        for (int u = 0; u < 2; ++u)
#pragma unroll
            for (int d = 0; d < 2; ++d)
#pragma unroll
                for (int r = 0; r < 16; ++r) o[u][d][r] = 0.f;
        const int kt_lo = (nb == 0) ? 2 : 0;
        auto tile_row = [&](int kt) -> long {
            return kt < 6 ? (long)b * SEQ + (nb - 1 + (kt >> 1)) * 128 + (kt & 1) * 64 : (long)T + b * LC + (kt - 6) * 64; };
        auto next_tile = [&](int kt) -> int { int n = kt + 1; if (nb == 31 && (n == 4 || n == 5)) n = 6; return n; };
        v4u kreg, vreg;
        auto LOADKV = [&](int kt) { const bf16* rp = PROJ + (size_t)(tile_row(kt) + skey) * INW + 512 + hkv * 64 + sch * 8; kreg = *(const v4u*)rp; vreg = *(const v4u*)(rp + 128); };
        int kt = kt_lo, nbuf = 0;
        LOADKV(kt);
        while (kt < 10) {
            LAS unsigned char* Kl = F.lds + AT_KB + nbuf * 8192; LAS unsigned char* Vl = F.lds + AT_VB + nbuf * 8192;
            *(LAS v4u*)(Kl + kdst) = kreg; *(LAS v4u*)(Vl + vdst) = vreg;
            __syncthreads();
            const int ktn = next_tile(kt);
            if (ktn < 10) LOADKV(ktn);
            const bool local = kt < 6; const int kpos0 = (nb - 1 + (kt >> 1)) * 128 + (kt & 1) * 64;
#pragma unroll
            for (int u = 0; u < 2; ++u) {
                f32x16 p0, p1;
#pragma unroll
                for (int r = 0; r < 16; ++r) { p0[r] = 0.f; p1[r] = 0.f; }
#pragma unroll
                for (int ks = 0; ks < 4; ++ks) { const int ch = 2 * ks + hi;
                    const bf16x8 k0 = *(const LAS bf16x8*)(Kl + r32 * 128 + ((ch ^ ((r32 >> 1) & 7)) << 4));
                    const bf16x8 k1 = *(const LAS bf16x8*)(Kl + (32 + r32) * 128 + ((ch ^ (((32 + r32) >> 1) & 7)) << 4));
                    p0 = __builtin_amdgcn_mfma_f32_32x32x16_bf16(k0, qf[u][ks], p0, 0, 0, 0);
                    p1 = __builtin_amdgcn_mfma_f32_32x32x16_bf16(k1, qf[u][ks], p1, 0, 0, 0); }
                if (local) { const int qp = q0 + 32 * u + r32;
#pragma unroll
                    for (int r = 0; r < 16; ++r) { const int kp = kpos0 + crow16(r, hi); const int d0 = qp - kp, d1 = qp - (kp + 32);
                        if (d0 > 128 || d0 < -128) p0[r] = -INFINITY; if (d1 > 128 || d1 < -128) p1[r] = -INFINITY; } }
                float mx = fmaxf(p0[0], p1[0]);
#pragma unroll
                for (int r = 1; r < 16; ++r) mx = fmaxf(mx, fmaxf(p0[r], p1[r]));
                mx = fmaxf(mx, __shfl_xor(mx, 32));
                const float mnew = fmaxf(m2[u], mx * C2);
                if (__any(mnew > m2[u])) {
                    const float alpha = __builtin_amdgcn_exp2f(m2[u] - mnew); lsum[u] *= alpha; m2[u] = mnew;
                    if (hi == 0) wsf[r32] = alpha;
                    LDS_FENCE();
#pragma unroll
                    for (int r = 0; r < 16; ++r) { const float a = wsf[crow16(r, hi)]; o[u][0][r] *= a; o[u][1][r] *= a; }
                    LDS_FENCE();
                }
                float ps = 0.f;
#pragma unroll
                for (int r = 0; r < 16; ++r) { p0[r] = __builtin_amdgcn_exp2f(p0[r] * C2 - m2[u]); p1[r] = __builtin_amdgcn_exp2f(p1[r] * C2 - m2[u]); ps += p0[r] + p1[r]; }
                lsum[u] += ps;
                bf16x8 pa[4];
#pragma unroll
                for (int s = 0; s < 2; ++s) {
                    v4u a, c2;
                    a.x = pk2(p0[8 * s + 0], p0[8 * s + 1]); a.y = pk2(p0[8 * s + 2], p0[8 * s + 3]); a.z = pk2(p0[8 * s + 4], p0[8 * s + 5]); a.w = pk2(p0[8 * s + 6], p0[8 * s + 7]);
                    c2.x = pk2(p1[8 * s + 0], p1[8 * s + 1]); c2.y = pk2(p1[8 * s + 2], p1[8 * s + 3]); c2.z = pk2(p1[8 * s + 4], p1[8 * s + 5]); c2.w = pk2(p1[8 * s + 6], p1[8 * s + 7]);
                    pa[s] = __builtin_bit_cast(bf16x8, a); pa[2 + s] = __builtin_bit_cast(bf16x8, c2); }
#pragma unroll
                for (int d0 = 0; d0 < 2; ++d0)
#pragma unroll
                    for (int ks = 0; ks < 4; ++ks) {
                        const int row = 16 * ks + 4 * hi + ((lane & 15) >> 2); const int dcol = 32 * d0 + 16 * ((lane >> 4) & 1) + 4 * (lane & 3);
                        const int ch = dcol >> 3, wi = (dcol & 7) * 2;
                        const s16x4 lo = ds_tr16(Vl + row * 128 + ((ch ^ (((row >> 1) & 1) << 2)) << 4) + wi);
                        const int row2 = row + 8;
                        const s16x4 hh = ds_tr16(Vl + row2 * 128 + ((ch ^ (((row2 >> 1) & 1) << 2)) << 4) + wi);
                        const bf16x8 vb = (bf16x8){lo[0], lo[1], lo[2], lo[3], hh[0], hh[1], hh[2], hh[3]};
                        o[u][d0] = __builtin_amdgcn_mfma_f32_32x32x16_bf16(pa[ks], vb, o[u][d0], 0, 0, 0); }
            }
            kt = ktn; nbuf ^= 1;
        }
#pragma unroll
        for (int u = 0; u < 2; ++u) {
            const float lt = lsum[u] + __shfl_xor(lsum[u], 32);
            if (hi == 0) wsf[r32] = 1.0f / lt;
            LDS_FENCE();
#pragma unroll
            for (int r = 0; r < 16; ++r) { const float a = wsf[crow16(r, hi)]; const size_t row = (size_t)b * SEQ + q0 + 32 * u + crow16(r, hi);
                ATT[row * 512 + hq * 64 + r32] = o[u][0][r] * a; ATT[row * 512 + hq * 64 + 32 + r32] = o[u][1][r] * a; }
            LDS_FENCE();
        }
        __syncthreads();
    }
}

#ifndef FUSED
#define FUSED 1
#endif
#ifndef NAIVE_ATTN
#define NAIVE_ATTN 0
#endif
#ifndef NAIVE_HYENA
#define NAIVE_HYENA 0
#endif
constexpr int NPHASES = 12;
__global__ void __launch_bounds__(NTHR, 2) fwd(Args args) {
    extern __shared__ __attribute__((aligned(16))) unsigned char lds[];
    Frame F;
    F.lds = (LAS unsigned char*)lds;
    F.tid = threadIdx.x; F.lane = F.tid & 63; F.wave = __builtin_amdgcn_readfirstlane(F.tid >> 6);
    F.gw = blockIdx.x * NWAVES + F.wave; F.ngw = gridDim.x * NWAVES;
#pragma unroll
    for (int i = 0; i < 32; ++i) F.in[i] = args.in[i];
    F.out = args.out; F.ws = args.ws;
    const int lo = args.ph_lo, hi = args.ph_hi;
#if FUSED
    cg::grid_group grid = cg::this_grid();
    if (F.tid < 2) ((volatile LAS unsigned*)(F.lds + MISC_OFF + 256))[F.tid] = 0u;
    __syncthreads();
    XcdBarrier bar = xcd_barrier_post((unsigned*)(F.ws + WS_CTL) + CW_BAR, (volatile LAS unsigned*)(F.lds + MISC_OFF + 256));
    unsigned long long* const tsw = (unsigned long long*)(F.ws + WS_CTL + CW_TS_BYTES);
#define STAMP(k) do { if (PROBE_A >= 0 && blockIdx.x == 0 && F.tid == 0) tsw[k] = __builtin_amdgcn_s_memrealtime(); } while (0)
#define SEAM(k) do { if (lo <= (k) && (k) + 1 < hi) { if ((k) == 0) grid.sync(); else xcd_barrier(bar); } STAMP((k) + 1); } while (0)
#else
#define STAMP(k) do { } while (0)
#define SEAM(k) do { } while (0)
#endif
#define IN(k) (lo <= (k) && (k) < hi)
    bf16* const H1 = (bf16*)(F.ws + WS_H1); bf16* const PROJ = (bf16*)(F.ws + WS_PROJ); bf16* const A2 = (bf16*)(F.ws + WS_A2);
    bf16* const XS = (bf16*)(F.ws + WS_XS); bf16* const HID = (bf16*)(F.ws + WS_HID);

    STAMP(0);
    if (IN(0)) { ph_mod(F); SEAM(0); }
    if (IN(1)) { ph_transposes(F); __syncthreads(); ph_filter(F); __syncthreads(); ph_h1(F); SEAM(1); }
    if (IN(2)) {
        pg8::Gemm g{H1, (const bf16*)(F.ws + WS_WIN), MROWS, INW, DM}; pg8::StaticOrder S; S.init(MROWS, INW, (int)gridDim.x, (int)blockIdx.x);
        pg8::EpiStore E{PROJ, INW};
        pg8::gemm_phase<pg8::EpiStore, pg8::StaticOrder, true, true>(F.lds, g, S, E);
        SEAM(2);
    }
    if (IN(3)) { ph_qkpost(F); ph_zprep(F); SEAM(3); }
    if (IN(4)) {
#if NAIVE_ATTN
        ph_attn_naive(F);
#else
        ph_attn_mfma(F);
#endif
        __syncthreads();
#if NAIVE_HYENA
        ph_hyena_naive(F);
#else
        ph_hyena_mfma(F);
#endif
        SEAM(4); }
    if (IN(5)) { ph_merge(F); SEAM(5); }
    if (IN(6)) {
        pg8::Gemm g{A2, (const bf16*)(F.ws + WS_WOUT), T, DM, DM}; pg8::StaticOrder S; S.init(T, DM, (int)gridDim.x, (int)blockIdx.x);
        pg8::EpiResid E{F.in[IN_X], F.out, (const float*)(F.ws + WS_MOD)};
        pg8::gemm_phase<pg8::EpiResid, pg8::StaticOrder, true, true>(F.lds, g, S, E);
        SEAM(6);
    }
    if (IN(7)) { ph_router(F); SEAM(7); }
    if (IN(8)) { ph_gather(F); SEAM(8); }
    if (IN(9)) {
        build_tile_table(F);
        pg8::Gemm g{XS, (const bf16*)(F.ws + WS_WGU), PMAX, 2048, DM};
        pg8::MoeOrder S{(const LAS int*)(F.lds + MISC_OFF), 8, (int)gridDim.x, (int)blockIdx.x, (size_t)2048 * 1024 * 2};
        pg8::EpiSwiglu E{HID, F.in[IN_BGU]};
        pg8::gemm_phase<pg8::EpiSwiglu, pg8::MoeOrder, true, true>(F.lds, g, S, E);
        SEAM(9);
    }
    if (IN(10)) {
        build_tile_table(F);
        pg8::Gemm g{HID, (const bf16*)(F.ws + WS_WD), PMAX, DM, DM};
        pg8::MoeOrder S{(const LAS int*)(F.lds + MISC_OFF), 4, (int)gridDim.x, (int)blockIdx.x, (size_t)1024 * 1024 * 2};
        pg8::EpiStoreBias E{XS, DM, F.in[IN_BDOWN], DM};
        pg8::gemm_phase<pg8::EpiStoreBias, pg8::MoeOrder, true, true>(F.lds, g, S, E);
        SEAM(10);
    }
    if (IN(11)) { ph_combine(F); }
#undef IN
#undef SEAM
}

extern "C" void kernel_launch(void* const* d_in, const int* in_sizes, int n_in, void* d_out, int out_size, void* d_ws, size_t ws_size, hipStream_t stream) {
    static int grid = 0;
    if (grid == 0) {
        if (n_in != 32 || out_size != T * DM || ws_size < WS_END) { fprintf(stderr, "kernel_launch: unexpected shapes n_in %d out %d ws %zu\n", n_in, out_size, ws_size); grid = -1; return; }
        int dev = 0, cus = 0, per_cu = 0;
        hipGetDevice(&dev); hipDeviceGetAttribute(&cus, hipDeviceAttributeMultiprocessorCount, dev);
        if (hipFuncSetAttribute((const void*)fwd, hipFuncAttributeMaxDynamicSharedMemorySize, LDS_BYTES) != hipSuccess) { fprintf(stderr, "kernel_launch: hipFuncSetAttribute failed\n"); grid = -1; return; }
        if (hipOccupancyMaxActiveBlocksPerMultiprocessor(&per_cu, (const void*)fwd, NTHR, LDS_BYTES) != hipSuccess || per_cu < 1) { fprintf(stderr, "kernel_launch: occupancy query says %d\n", per_cu); per_cu = 1; }
        (void)hipGetLastError();
        grid = cus * 1;
    }
    if (grid < 0) return;
    hipMemsetAsync((char*)d_ws + WS_CTL, 0, CTL_ZERO_BYTES, stream);
    Args a{};
    for (int i = 0; i < 32; ++i) a.in[i] = (const float*)d_in[i];
    a.out = (float*)d_out; a.ws = (unsigned char*)d_ws;
#if FUSED
    a.ph_lo = 0; a.ph_hi = NPHASES;
    void* kargs[] = {&a};
    hipError_t e = hipLaunchCooperativeKernel((const void*)fwd, dim3(grid), dim3(NTHR), kargs, LDS_BYTES, stream);
    if (e != hipSuccess) fprintf(stderr, "cooperative launch failed: %s (grid %d)\n", hipGetErrorString(e), grid);
#else
    for (int p = 0; p < NPHASES; ++p) { a.ph_lo = p; a.ph_hi = p + 1; hipLaunchKernelGGL(fwd, dim3(grid), dim3(NTHR), LDS_BYTES, stream, a); }
#endif
}
```

```cpp
#include <hip/hip_runtime.h>
#include <hip/hip_cooperative_groups.h>
#include <cstdio>
#include <cstdint>
#include <cmath>
namespace cg = cooperative_groups;
#ifndef PROBE_A
#define PROBE_A -1
#endif
#ifndef PROBE_B
#define PROBE_B -1
#endif
#ifndef CG_SEAMS
#define CG_SEAMS 1
#endif
#ifndef DBL
#define DBL -1
#endif
#ifndef XB_EARLY_REL
#define XB_EARLY_REL 1
#endif
namespace pg8 {
#define PG8_LAS __attribute__((address_space(3)))
typedef unsigned short bf16_t;
typedef short bf16x8 __attribute__((ext_vector_type(8)));
typedef float f32x4 __attribute__((ext_vector_type(4)));
typedef unsigned u32x4 __attribute__((ext_vector_type(4)));
constexpr int BM = 256, BK = 64, HALF = 128, HTB = HALF * BK * 2  , STAGE_BYTES = 8 * HTB, NXCD = 8, WGM = 8;

__host__ __device__ __forceinline__ int lds_byte(int r, int c) { const int st = (r >> 4) * 2 + (c >> 5), rr = r & 15, cc = c & 31, ob = rr * 64 + cc * 2; return st * 1024 + (ob ^ (((ob >> 9) & 1) << 5)); }
__host__ __device__ __forceinline__ void stage_rc(int b, int& R, int& C) { const int st = b / 1024, sb = b % 1024, swz = sb ^ (((sb >> 9) & 1) << 5); R = (st >> 1) * 16 + swz / 64; C = (st & 1) * 32 + (swz % 64) / 2; }
__host__ __device__ __forceinline__ int perm32(int rho) { const int n = rho >> 4, i = rho & 15; return 8 * (i >> 2) + 4 * n + (i & 3); }

struct Unit { int pm, pn, e; };
struct Gemm { const bf16_t* A; const bf16_t* Bt; int M, N, K; };

struct StaticOrder {
    int nM, nN, nwg, G, c;
    __host__ __device__ void init(int M, int N, int G_, int c_) { nM = M / BM; nN = N / BM; nwg = nM * nN; G = G_; c = c_; }
    __host__ __device__ bool next(int i, Unit& u) const {
        const long L = (long)i * G + c; if (L >= nwg) return false;
        int wgid = (int)L; { const int q = nwg / NXCD, r = nwg % NXCD, xcd = wgid % NXCD, off = wgid / NXCD; wgid = (xcd < r ? xcd * (q + 1) : r * (q + 1) + (xcd - r) * q) + off; }
        const int nig = WGM * nN, gid = wgid / nig, fm = gid * WGM, gsz = (nM - fm) < WGM ? (nM - fm) : WGM;
        u.pm = fm + ((wgid % nig) % gsz); u.pn = (wgid % nig) / gsz; u.e = 0; return true;
    }
    __device__ __forceinline__ size_t a_off(const Unit& u, size_t tstep) const { return (size_t)u.pm * tstep; }
    __device__ __forceinline__ size_t b_off(const Unit& u, size_t tstep) const { return (size_t)u.pn * tstep; }
    __device__ __forceinline__ void a_ready(const Unit&) const {}
    __device__ __forceinline__ void done(const Unit&) const {}
};

__device__ __forceinline__ unsigned cvt_pk_bf16(float lo, float hi) { unsigned r; asm volatile("v_cvt_pk_bf16_f32 %0, %1, %2" : "=v"(r) : "v"(lo), "v"(hi)); return r; }

template <class Epi, class Sched, bool ALIGN_EPI = false, bool SP2 = false>
__device__ __forceinline__ void gemm_phase(PG8_LAS unsigned char* lds, const Gemm g, const Sched& S, const Epi& E) {
    const int tid = threadIdx.x, wid = __builtin_amdgcn_readfirstlane(tid >> 6), lane = tid & 63, wr = wid >> 2, wc = wid & 3, fr = lane & 15, fq = lane >> 4;
    const int K = g.K, nt = K / BK;
    unsigned voffA[2], voffB[2];
#pragma unroll
    for (int i = 0; i < 2; ++i) { int R, C; stage_rc(tid * 16 + i * 8192, R, C); const int Rb = Epi::PERM ? ((R & ~31) + perm32(R & 31)) : R;
        voffA[i] = (unsigned)(R * K + C) * 2u; voffB[i] = (unsigned)(Rb * K + C) * 2u; }
    const size_t kstep = (size_t)(BK * 2);
    const size_t hstep = (size_t)HALF * K * 2;
    const size_t tstep = 2 * hstep;
    const unsigned ldsw = (unsigned)wid * 1024u;
    const int aoff = lds_byte(wr * 64 + fr, fq * 8), boff = lds_byte(wc * 32 + fr, fq * 8);
#define PG8_SA(b, h) (((b) * 2 + (h)) * HTB)
#define PG8_SB(b, h) ((4 + (b) * 2 + (h)) * HTB)
#define PG8_STAGE(bufoff, gbase, voff) do { _Pragma("unroll") for (int _i = 0; _i < 2; ++_i) \
        __builtin_amdgcn_global_load_lds((const unsigned*)((const char*)(gbase) + (voff)[_i]), (PG8_LAS unsigned*)(lds + (bufoff) + ldsw + _i * 8192), 16, 0, 0); } while (0)
#define PG8_LDA(dst, b, h) do { _Pragma("unroll") for (int m = 0; m < 4; ++m) _Pragma("unroll") for (int k = 0; k < 2; ++k) dst[m][k] = *(const PG8_LAS bf16x8*)(lds + PG8_SA(b, h) + aoff + m * 2048 + k * 1024); } while (0)
#define PG8_LDB(dst, b, h) do { _Pragma("unroll") for (int n = 0; n < 2; ++n) _Pragma("unroll") for (int k = 0; k < 2; ++k) dst[n][k] = *(const PG8_LAS bf16x8*)(lds + PG8_SB(b, h) + boff + n * 2048 + k * 1024); } while (0)
#define PG8_MMA(ai, bj, At, Bt) do { __builtin_amdgcn_s_setprio(1); _Pragma("unroll") for (int m = 0; m < 4; ++m) _Pragma("unroll") for (int n = 0; n < 2; ++n) _Pragma("unroll") for (int k = 0; k < 2; ++k) \
        acc[ai][bj][m][n] = __builtin_amdgcn_mfma_f32_16x16x32_bf16(Bt[n][k], At[m][k], acc[ai][bj][m][n], 0, 0, 0); __builtin_amdgcn_s_setprio(0); } while (0)
#define PG8_WAIT_V(n) asm volatile("s_waitcnt vmcnt(" #n ")" ::: "memory")
#define PG8_WAIT_L(n) asm volatile("s_waitcnt lgkmcnt(" #n ")" ::: "memory")
#define PG8_BAR __builtin_amdgcn_s_barrier()
#define PG8_SCHED __builtin_amdgcn_sched_barrier(0)
    Unit cur, nxt; int ui = 0;
    if (!S.next(0, cur)) return;
    f32x4 acc[2][2][4][2];
#pragma unroll
    for (int a = 0; a < 2; ++a)
#pragma unroll
        for (int b = 0; b < 2; ++b)
#pragma unroll
            for (int m = 0; m < 4; ++m)
#pragma unroll
                for (int n = 0; n < 2; ++n) acc[a][b][m][n] = (f32x4){0.f, 0.f, 0.f, 0.f};
    bf16x8 At[4][2], B0[2][2], B1[2][2];
    const char* cA = (const char*)g.A + S.a_off(cur, tstep); const char* cB = (const char*)g.Bt + S.b_off(cur, tstep);
    S.a_ready(cur);
    if constexpr (SP2) {
        PG8_STAGE(PG8_SB(0, 0), cB, voffB); PG8_STAGE(PG8_SB(0, 1), cB + hstep, voffB); PG8_STAGE(PG8_SA(0, 0), cA, voffA); PG8_STAGE(PG8_SA(0, 1), cA + hstep, voffA);
        if (wr == 1) PG8_BAR;
        PG8_WAIT_V(2); PG8_BAR;
        PG8_STAGE(PG8_SB(1, 0), cB + kstep, voffB); PG8_STAGE(PG8_SA(1, 0), cA + kstep, voffA); PG8_STAGE(PG8_SB(1, 1), cB + hstep + kstep, voffB);
        PG8_WAIT_V(6); PG8_BAR;
    } else {
        PG8_STAGE(PG8_SB(0, 0), cB, voffB); PG8_STAGE(PG8_SA(0, 0), cA, voffA); PG8_STAGE(PG8_SB(0, 1), cB + hstep, voffB); PG8_STAGE(PG8_SA(0, 1), cA + hstep, voffA);
        if (wr == 1) PG8_BAR;
        PG8_WAIT_V(4); PG8_BAR;
        PG8_STAGE(PG8_SB(1, 0), cB + kstep, voffB); PG8_STAGE(PG8_SA(1, 0), cA + kstep, voffA); PG8_STAGE(PG8_SB(1, 1), cB + hstep + kstep, voffB);
        PG8_WAIT_V(6); PG8_BAR;
    }
    for (;;) {
        const bool has_next = S.next(ui + 1, nxt);
        const char* nA = has_next ? (const char*)g.A + S.a_off(nxt, tstep) : cA; const char* nB = has_next ? (const char*)g.Bt + S.b_off(nxt, tstep) : cB;
        for (int t = 0; t < nt; t += 2) {
            const bool last = (t == nt - 2);
            const char* a1 = cA + (size_t)(t + 1) * kstep;
            const char* a2 = last ? nA : cA + (size_t)(t + 2) * kstep; const char* b2 = last ? nB : cB + (size_t)(t + 2) * kstep;
            const char* a3 = a2 + kstep; const char* b3 = b2 + kstep;
            if (last && has_next) S.a_ready(nxt);
            if constexpr (SP2) {
            PG8_LDB(B0, 0, 0); PG8_LDB(B1, 0, 1); PG8_SCHED; PG8_LDA(At, 0, 0); PG8_STAGE(PG8_SA(1, 1), a1 + hstep, voffA);
            PG8_WAIT_V(8); PG8_WAIT_L(0); PG8_BAR; PG8_MMA(0, 0, At, B0); PG8_MMA(0, 1, At, B1); PG8_BAR; PG8_SCHED;
            PG8_LDA(At, 0, 1); PG8_STAGE(PG8_SB(0, 0), b2, voffB); PG8_STAGE(PG8_SB(0, 1), b2 + hstep, voffB); PG8_STAGE(PG8_SA(0, 0), a2, voffA);
            PG8_WAIT_V(8); PG8_WAIT_L(0); PG8_BAR; PG8_MMA(1, 0, At, B0); PG8_MMA(1, 1, At, B1); PG8_BAR; PG8_SCHED;
            PG8_LDB(B0, 1, 0); PG8_LDB(B1, 1, 1); PG8_SCHED; PG8_LDA(At, 1, 0); PG8_STAGE(PG8_SA(0, 1), a2 + hstep, voffA);
            PG8_WAIT_V(8); PG8_WAIT_L(0); PG8_BAR; PG8_MMA(0, 0, At, B0); PG8_MMA(0, 1, At, B1); PG8_BAR; PG8_SCHED;
            PG8_LDA(At, 1, 1); PG8_STAGE(PG8_SB(1, 0), b3, voffB); PG8_STAGE(PG8_SB(1, 1), b3 + hstep, voffB); PG8_STAGE(PG8_SA(1, 0), a3, voffA);
            PG8_WAIT_V(8); PG8_WAIT_L(0); PG8_BAR; PG8_MMA(1, 0, At, B0); PG8_MMA(1, 1, At, B1); PG8_BAR; PG8_SCHED;
            } else {
            PG8_LDB(B0, 0, 0); PG8_SCHED; PG8_LDA(At, 0, 0); PG8_STAGE(PG8_SA(1, 1), a1 + hstep, voffA);
            PG8_WAIT_L(8); PG8_BAR; PG8_WAIT_L(0); PG8_MMA(0, 0, At, B0); PG8_BAR; PG8_SCHED;
            PG8_LDB(B1, 0, 1); PG8_STAGE(PG8_SB(0, 0), b2, voffB);
            PG8_BAR; PG8_WAIT_L(0); PG8_MMA(0, 1, At, B1); PG8_BAR;
            PG8_LDA(At, 0, 1); PG8_STAGE(PG8_SA(0, 0), a2, voffA);
            PG8_BAR; PG8_WAIT_L(0); PG8_MMA(1, 0, At, B0); PG8_BAR; PG8_SCHED;
            PG8_STAGE(PG8_SB(0, 1), b2 + hstep, voffB);
            PG8_WAIT_V(6); PG8_BAR; PG8_MMA(1, 1, At, B1); PG8_BAR;
            PG8_LDB(B0, 1, 0); PG8_SCHED; PG8_LDA(At, 1, 0); PG8_STAGE(PG8_SA(0, 1), a2 + hstep, voffA);
            PG8_WAIT_L(8); PG8_BAR; PG8_WAIT_L(0); PG8_MMA(0, 0, At, B0); PG8_BAR; PG8_SCHED;
            PG8_LDB(B1, 1, 1); PG8_STAGE(PG8_SB(1, 0), b3, voffB);
            PG8_BAR; PG8_WAIT_L(0); PG8_MMA(0, 1, At, B1); PG8_BAR;
            PG8_LDA(At, 1, 1); PG8_STAGE(PG8_SA(1, 0), a3, voffA);
            PG8_BAR; PG8_WAIT_L(0); PG8_MMA(1, 0, At, B0); PG8_BAR; PG8_SCHED;
            PG8_STAGE(PG8_SB(1, 1), b3 + hstep, voffB);
            PG8_WAIT_V(6); PG8_BAR; PG8_MMA(1, 1, At, B1); PG8_BAR;
            }
        }
        if constexpr (ALIGN_EPI) { if (wr == 0) PG8_BAR; }
        if constexpr (!Epi::AFTER_DRAIN) { E(acc, cur, wr, wc, fr, fq); S.done(cur); }
        if (!has_next) break;
#pragma unroll
        for (int a = 0; a < 2; ++a)
#pragma unroll
            for (int b = 0; b < 2; ++b)
#pragma unroll
                for (int m = 0; m < 4; ++m)
#pragma unroll
                    for (int n = 0; n < 2; ++n) acc[a][b][m][n] = (f32x4){0.f, 0.f, 0.f, 0.f};
        cur = nxt; cA = nA; cB = nB; ++ui;
        if constexpr (ALIGN_EPI) { if (wr == 1) PG8_BAR; }
    }
    PG8_WAIT_V(0);
    if constexpr (!ALIGN_EPI) { if (wr == 0) PG8_BAR; }
    PG8_BAR;
    if constexpr (Epi::AFTER_DRAIN) { E.fused(acc, cur, wr, wc, fr, fq, lds, wid, lane); S.done(cur); }
#undef PG8_SA
#undef PG8_SB
#undef PG8_STAGE
#undef PG8_LDA
#undef PG8_LDB
#undef PG8_MMA
#undef PG8_WAIT_V
#undef PG8_WAIT_L
#undef PG8_BAR
#undef PG8_SCHED
}
}
namespace pg8 {
typedef unsigned u32x4 __attribute__((ext_vector_type(4)));
struct EpiStore {
    static constexpr bool PERM = true, AFTER_DRAIN = false;
    bf16_t* O; int ldc;
    __device__ __forceinline__ void operator()(const f32x4 (&acc)[2][2][4][2], const Unit& u, int wr, int wc, int fr, int fq) const {
        const int row0 = u.pm * BM + wr * 64 + fr; const int col0 = u.pn * BM + wc * 32 + 8 * fq;
#pragma unroll
        for (int ai = 0; ai < 2; ++ai)
#pragma unroll
            for (int m = 0; m < 4; ++m) { bf16_t* rowp = O + (size_t)(row0 + ai * HALF + m * 16) * ldc + col0;
#pragma unroll
                for (int bj = 0; bj < 2; ++bj) { const f32x4 v0 = acc[ai][bj][m][0], v1 = acc[ai][bj][m][1];
                    u32x4 w; w.x = cvt_pk_bf16(v0[0], v0[1]); w.y = cvt_pk_bf16(v0[2], v0[3]); w.z = cvt_pk_bf16(v1[0], v1[1]); w.w = cvt_pk_bf16(v1[2], v1[3]);
                    *(u32x4*)(rowp + bj * HALF) = w; } }
    }
};
struct EpiStoreBias {
    static constexpr bool PERM = true, AFTER_DRAIN = false;
    bf16_t* O; int ldc; const float* bias; int bstride;
    __device__ __forceinline__ void operator()(const f32x4 (&acc)[2][2][4][2], const Unit& u, int wr, int wc, int fr, int fq) const {
        const int row0 = u.pm * BM + wr * 64 + fr; const int col0 = u.pn * BM + wc * 32 + 8 * fq;
        const float* bp = bias + (size_t)u.e * bstride + col0;
        f32x4 bv[2][2];
#pragma unroll
        for (int bj = 0; bj < 2; ++bj)
#pragma unroll
            for (int n = 0; n < 2; ++n) bv[bj][n] = *(const f32x4*)(bp + bj * HALF + 4 * n);
#pragma unroll
        for (int ai = 0; ai < 2; ++ai)
#pragma unroll
            for (int m = 0; m < 4; ++m) { bf16_t* rowp = O + (size_t)(row0 + ai * HALF + m * 16) * ldc + col0;
#pragma unroll
                for (int bj = 0; bj < 2; ++bj) { const f32x4 v0 = acc[ai][bj][m][0] + bv[bj][0], v1 = acc[ai][bj][m][1] + bv[bj][1];
                    u32x4 w; w.x = cvt_pk_bf16(v0[0], v0[1]); w.y = cvt_pk_bf16(v0[2], v0[3]); w.z = cvt_pk_bf16(v1[0], v1[1]); w.w = cvt_pk_bf16(v1[2], v1[3]);
                    *(u32x4*)(rowp + bj * HALF) = w; } }
    }
};
struct EpiResid {
    static constexpr bool PERM = false, AFTER_DRAIN = false;
    const float* x; float* out; const float* mod;
    __device__ __forceinline__ void operator()(const f32x4 (&acc)[2][2][4][2], const Unit& u, int wr, int wc, int fr, int fq) const {
        const int col0 = u.pn * BM + wc * 32 + 4 * fq;
        const int b = (u.pm * BM) >> 12;
        const float* g1 = mod + (size_t)b * 6144 + 2048 + col0;
        f32x4 gv[2][2];
#pragma unroll
        for (int bj = 0; bj < 2; ++bj)
#pragma unroll
            for (int n = 0; n < 2; ++n) gv[bj][n] = *(const f32x4*)(g1 + bj * HALF + n * 16);
#pragma unroll
        for (int ai = 0; ai < 2; ++ai)
#pragma unroll
            for (int m = 0; m < 4; ++m) { const size_t off = (size_t)(u.pm * BM + ai * HALF + wr * 64 + m * 16 + fr) * 1024 + col0;
#pragma unroll
                for (int bj = 0; bj < 2; ++bj)
#pragma unroll
                    for (int n = 0; n < 2; ++n) { const f32x4 xv = *(const f32x4*)(x + off + bj * HALF + n * 16);
                        *(f32x4*)(out + off + bj * HALF + n * 16) = xv + gv[bj][n] * acc[ai][bj][m][n]; } }
    }
};
struct EpiSwiglu {
    static constexpr bool PERM = true, AFTER_DRAIN = false;
    bf16_t* O; const float* bgu;
    __device__ __forceinline__ void operator()(const f32x4 (&acc)[2][2][4][2], const Unit& u, int wr, int wc, int fr, int fq) const {
        const int row0 = u.pm * BM + wr * 64 + fr; const int hc0 = u.pn * HALF + wc * 32 + 8 * fq;
        const float* bg = bgu + (size_t)u.e * 2048 + hc0;
        f32x4 bgv[2], buv[2];
#pragma unroll
        for (int n = 0; n < 2; ++n) { bgv[n] = *(const f32x4*)(bg + 4 * n); buv[n] = *(const f32x4*)(bg + 1024 + 4 * n); }
#pragma unroll
        for (int ai = 0; ai < 2; ++ai)
#pragma unroll
            for (int m = 0; m < 4; ++m) { bf16_t* rowp = O + (size_t)(row0 + ai * HALF + m * 16) * 1024 + hc0;
                float h[8];
#pragma unroll
                for (int n = 0; n < 2; ++n) { const f32x4 g4 = acc[ai][0][m][n] + bgv[n], u4 = acc[ai][1][m][n] + buv[n];
#pragma unroll
                    for (int j = 0; j < 4; ++j) { const float g = fminf(g4[j], 7.0f); const float up = fminf(fmaxf(u4[j], -7.0f), 7.0f);
                        const float glu = g / (1.0f + __expf(-1.702f * g)); h[4 * n + j] = (up + 1.0f) * glu; } }
                u32x4 w; w.x = cvt_pk_bf16(h[0], h[1]); w.y = cvt_pk_bf16(h[2], h[3]); w.z = cvt_pk_bf16(h[4], h[5]); w.w = cvt_pk_bf16(h[6], h[7]);
                *(u32x4*)rowp = w; }
    }
};
struct MoeOrder {
    const PG8_LAS int* tstart; int nN, G, c; size_t estride;
    __device__ __forceinline__ bool next(int i, Unit& u) const {
        const int nMt = tstart[32]; const long L = (long)i * G + c; if (L >= (long)nMt * nN) return false;
        const int pm = (int)(L / nN), pn = (int)(L % nN); int e = 0;
#pragma unroll 1
        for (int k = 1; k < 32; ++k) e += (pm >= tstart[k]) ? 1 : 0;
        u.pm = __builtin_amdgcn_readfirstlane(pm); u.pn = __builtin_amdgcn_readfirstlane(pn); u.e = __builtin_amdgcn_readfirstlane(e); return true;
    }
    __device__ __forceinline__ size_t a_off(const Unit& u, size_t tstep) const { return (size_t)u.pm * tstep; }
    __device__ __forceinline__ size_t b_off(const Unit& u, size_t tstep) const { return (size_t)u.e * estride + (size_t)u.pn * tstep; }
    __device__ __forceinline__ void a_ready(const Unit&) const {}
    __device__ __forceinline__ void done(const Unit&) const {}
};
}

constexpr int NB = 8, SEQ = 4096, DM = 1024, T = NB * SEQ, LC = 256, TC = NB * LC, MROWS = T + TC;
constexpr int INW = 2304, AW = 512, HW = 512, HD = 64, NE = 32, TOPK = 4;
constexpr float EPS = 1e-6f;
constexpr int PMAX = T * TOPK + NE * 256;
constexpr int NWAVES = 8, NTHR = 512;

constexpr size_t MiB = 1u << 20;
constexpr size_t WS_CTL = 0, CTL_ZERO_BYTES = 1 * MiB;
constexpr size_t WS_MOD = 1 * MiB;
constexpr size_t WS_WIN = 2 * MiB;
constexpr size_t WS_WOUT = 8 * MiB;
constexpr size_t WS_RG = 10 * MiB;
constexpr size_t WS_ROUTE = 18 * MiB;
constexpr size_t WS_WGU = 32 * MiB;
constexpr size_t WS_WD = 160 * MiB;
constexpr size_t WS_H1 = 224 * MiB;
constexpr size_t WS_PROJ = 296 * MiB;
constexpr size_t WS_A2 = 452 * MiB;
constexpr size_t WS_HID = 296 * MiB;
constexpr size_t WS_XS = 568 * MiB;
constexpr size_t WS_ZT = 840 * MiB;
constexpr size_t WS_X0T = 872 * MiB;
constexpr size_t WS_YT = 904 * MiB;
constexpr size_t WS_ATT = 936 * MiB;
constexpr size_t WS_END = 1000 * MiB;
constexpr int CW_CNT = 64;
constexpr int CW_NRM = 128;
constexpr int CW_BAR = 4096;
constexpr int CW_TS_BYTES = 65536;

constexpr int LDS_BYTES = 147456;
constexpr int RING_BYTES = 131072;
constexpr int MISC_OFF = RING_BYTES;

#define GAS __attribute__((address_space(1)))
#define LAS __attribute__((address_space(3)))
typedef unsigned short bf16;
typedef unsigned v4u __attribute__((ext_vector_type(4)));
typedef unsigned v2u __attribute__((ext_vector_type(2)));
typedef float f32x4 __attribute__((ext_vector_type(4)));
typedef short bf16x8 __attribute__((ext_vector_type(8)));

__device__ __forceinline__ unsigned f2bf(float f) { unsigned u = __builtin_bit_cast(unsigned, f); return (u + 0x7fffu + ((u >> 16) & 1u)) >> 16; }
__device__ __forceinline__ unsigned pk2(float lo, float hi) { return f2bf(lo) | (f2bf(hi) << 16); }
__device__ __forceinline__ float bf2f(unsigned h) { return __builtin_bit_cast(float, h << 16); }
__device__ __forceinline__ float bflo(unsigned w) { return __builtin_bit_cast(float, w << 16); }
__device__ __forceinline__ float bfhi(unsigned w) { return __builtin_bit_cast(float, w & 0xffff0000u); }
__device__ __forceinline__ float wave_sum(float v) {
#pragma unroll
    for (int o = 1; o < 64; o <<= 1) v += __shfl_xor(v, o);
    return v;
}
__device__ __forceinline__ float wave_max(float v) {
#pragma unroll
    for (int o = 1; o < 64; o <<= 1) v = fmaxf(v, __shfl_xor(v, o));
    return v;
}
#define LDS_FENCE() asm volatile("s_waitcnt lgkmcnt(0)" ::: "memory")

struct Args { const float* in[32]; float* out; unsigned char* ws; int ph_lo, ph_hi; };

struct Frame {
    LAS unsigned char* lds;
    int tid, lane, wave, gw, ngw;
    const float* in[32];
    float* out; unsigned char* ws;
};
#define XB_TMO      128
#define XB_XCNT(j)  (256  + 64 * (j))
#define XB_XSUB(j)  (1280 + 64 * (j))
#define XB_XGEN(j)  (2304 + 64 * (j))
#define XB_TOP      3328
#define XB_TOPGEN   3392
#define XCD_BAR_WORDS 3456
#define XB_SPIN_CAP (1u << 18)

__device__ __forceinline__ unsigned xb_ld(unsigned* p)              { return __hip_atomic_load(p, __ATOMIC_RELAXED, __HIP_MEMORY_SCOPE_AGENT); }
__device__ __forceinline__ unsigned xb_add(unsigned* p, unsigned v) { return __hip_atomic_fetch_add(p, v, __ATOMIC_RELAXED, __HIP_MEMORY_SCOPE_AGENT); }
__device__ __forceinline__ unsigned xb_xcc_id() { return (unsigned)__builtin_amdgcn_s_getreg((3 << 11) | 20) & 0xFu; }
#define XB_SPIN(cond, bar) do { unsigned _sp = 0; while (cond) { __builtin_amdgcn_s_sleep(1); \
    if ((++_sp & 255u) == 0u) { if (xb_ld(&(bar)[XB_TMO])) break; if (_sp > XB_SPIN_CAP) { atomicAdd(&(bar)[XB_TMO], 1u); break; } } } } while (0)

struct XcdBarrier {
    unsigned* bar; unsigned x;
    volatile LAS unsigned* st;
};

__device__ __forceinline__ XcdBarrier xcd_barrier_post(unsigned* bar, volatile LAS unsigned* st) {
    XcdBarrier b; b.bar = bar; b.x = xb_xcc_id(); b.st = st;
    if (threadIdx.x == 0) (void)xb_add(&bar[XB_XCNT(b.x)], 1u);
    return b;
}
__device__ __forceinline__ void xcd_barrier_complete(unsigned* bar, unsigned x, unsigned& nloc, unsigned& nx) {
    const unsigned G = gridDim.x * gridDim.y * gridDim.z;
    unsigned sum, cnt, mine, sp = 0u;
    for (;;) {
        sum = 0u; cnt = 0u; mine = 0u;
#pragma unroll
        for (unsigned j = 0; j < 16; ++j) { const unsigned c = xb_ld(&bar[XB_XCNT(j)]); sum += c; cnt += (c > 0u) ? 1u : 0u; mine = (j == x) ? c : mine; }
        if (sum == G) break;
        __builtin_amdgcn_s_sleep(1);
        if ((++sp & 255u) == 0u) { if (xb_ld(&bar[XB_TMO])) break; if (sp > XB_SPIN_CAP) { atomicAdd(&bar[XB_TMO], 1u); break; } }
    }
    nloc = mine > 0u ? mine : 1u; nx = cnt > 0u ? cnt : 1u;
}

__device__ __forceinline__ void xcd_barrier(const XcdBarrier& b) {
    asm volatile("s_waitcnt vmcnt(0)" ::: "memory");
    __syncthreads();
    if (threadIdx.x == 0) {
        unsigned* bar = b.bar;
        __builtin_amdgcn_s_waitcnt(0);
        unsigned nloc = b.st[0], nx = b.st[1];
        if (nloc == 0u) { xcd_barrier_complete(bar, b.x, nloc, nx); b.st[0] = nloc; b.st[1] = nx; }
        if (XB_EARLY_REL) { __builtin_amdgcn_fence(__ATOMIC_RELEASE, "agent"); asm volatile("s_waitcnt vmcnt(0)" ::: "memory"); }
        const unsigned old = xb_add(&bar[XB_XSUB(b.x)], 1u);
        const unsigned gen = old / nloc;
        if (old + 1u == (gen + 1u) * nloc) {
            __builtin_amdgcn_fence(__ATOMIC_RELEASE, "agent");
            asm volatile("s_waitcnt vmcnt(0)" ::: "memory");
            const unsigned og = xb_add(&bar[XB_TOP], 1u);
            const unsigned tg = og / nx;
            if (og + 1u == (tg + 1u) * nx) xb_add(&bar[XB_TOPGEN], 1u);
            else XB_SPIN(xb_ld(&bar[XB_TOPGEN]) == tg, bar);
            __builtin_amdgcn_fence(__ATOMIC_ACQUIRE, "agent");
            xb_add(&bar[XB_XGEN(b.x)], 1u);
            asm volatile("s_waitcnt vmcnt(0)" ::: "memory");
        } else {
            XB_SPIN(xb_ld(&bar[XB_XGEN(b.x)]) == gen, bar);
            __builtin_amdgcn_fence(__ATOMIC_ACQUIRE, "agent");
            asm volatile("s_waitcnt vmcnt(0)" ::: "memory");
        }
    }
    __syncthreads();
}

#define IN_X 0
#define IN_C 1
#define IN_CTX 2
#define IN_CCTX 3
#define IN_WMOD 4
#define IN_BMOD 5
#define IN_NORM1 6
#define IN_NORM2 7
#define IN_WIN 8
#define IN_QNORM 9
#define IN_KNORM 10
#define IN_SINK 11
#define IN_CONVW 12
#define IN_CONVB 13
#define IN_FW1 14
#define IN_FB1 15
#define IN_FW2 16
#define IN_FB2 17
#define IN_FW3 18
#define IN_FB3 19
#define IN_FW4 20
#define IN_FFREQ 21
#define IN_FBIAS 22
#define IN_ANORM 23
#define IN_YNORM 24
#define IN_WOUT 25
#define IN_WROUTER 26
#define IN_BROUTER 27
#define IN_WGU 28
#define IN_BGU 29
#define IN_WDOWN 30
#define IN_BDOWN 31

__device__ __forceinline__ void ph_mod(const Frame& F) {
    LAS float* sil = (LAS float*)F.lds;
    LAS float* part = sil + 9 * 1024;
    const float* c = F.in[IN_C]; const float* cc = F.in[IN_CCTX]; const float* wm = F.in[IN_WMOD]; const float* bm = F.in[IN_BMOD];
    float* MOD = (float*)(F.ws + WS_MOD);
    for (int i = F.tid; i < 9 * 1024; i += NTHR) { const int r = i >> 10, k = i & 1023; const float v = r < 8 ? c[r * 1024 + k] : cc[k]; sil[i] = v / (1.0f + expf(-v)); }
    __syncthreads();
    for (int item = blockIdx.x; item < 96; item += gridDim.x) {
        const int col = item * 64 + F.lane;
        float acc[9];
#pragma unroll
        for (int r = 0; r < 9; ++r) acc[r] = 0.f;
        for (int kk = 0; kk < 128; ++kk) { const int k = F.wave * 128 + kk; const float wv = wm[(size_t)k * 6144 + col];
#pragma unroll
            for (int r = 0; r < 9; ++r) acc[r] += sil[r * 1024 + k] * wv; }
#pragma unroll
        for (int r = 0; r < 9; ++r) part[(F.wave * 9 + r) * 64 + F.lane] = acc[r];
        __syncthreads();
        for (int i = F.tid; i < 9 * 64; i += NTHR) { const int r = i >> 6, l = i & 63; float s = bm[item * 64 + l];
            for (int w = 0; w < 8; ++w) s += part[(w * 9 + r) * 64 + l];
            MOD[r * 6144 + item * 64 + l] = s; }
        __syncthreads();
    }
}

__device__ __forceinline__ void transpose_item(const float* W, int K, int N, bf16* WT, int dst_row0, LAS float* scr, int k0, int n0, const float* kscale, int lane) {
#pragma unroll 8
    for (int i = 0; i < 32; ++i) { const int kk = 2 * i + (lane >> 5); float v = W[(size_t)(k0 + kk) * N + n0 + (lane & 31)]; if (kscale) v *= kscale[kk]; scr[kk * 33 + (lane & 31)] = v; }
    LDS_FENCE();
    const int c = lane & 7;
#pragma unroll
    for (int j = 0; j < 4; ++j) { const int n = (lane >> 3) + 8 * j; const LAS float* s = scr + (8 * c) * 33 + n;
        v4u o; o.x = pk2(s[0 * 33], s[1 * 33]); o.y = pk2(s[2 * 33], s[3 * 33]); o.z = pk2(s[4 * 33], s[5 * 33]); o.w = pk2(s[6 * 33], s[7 * 33]);
        *(v4u*)(WT + (size_t)(dst_row0 + n) * K + k0 + 8 * c) = o; }
    LDS_FENCE();
}
__device__ __forceinline__ void ph_transposes(const Frame& F) {
    LAS float* scr = (LAS float*)(F.lds) + F.wave * (64 * 33);
    bf16* WinT = (bf16*)(F.ws + WS_WIN); bf16* WoutT = (bf16*)(F.ws + WS_WOUT); bf16* WguT = (bf16*)(F.ws + WS_WGU); bf16* WdT = (bf16*)(F.ws + WS_WD);
    constexpr int I_IN = 16 * 72, I_OUT = 16 * 32, I_GU = 32 * 16 * 64, I_D = 32 * 16 * 32;
    constexpr int NITEMS = I_IN + I_OUT + I_GU + I_D;
    for (int it = F.gw; it < NITEMS; it += F.ngw) {
        int r = it;
        if (r < I_IN) { const int kb = r / 72, nb = r % 72; transpose_item(F.in[IN_WIN], 1024, INW, WinT, 32 * nb, scr, 64 * kb, 32 * nb, nullptr, F.lane); continue; } r -= I_IN;
        if (r < I_OUT) { const int kb = r / 32, nb = r % 32, k0 = 64 * kb; const float* ks = k0 < 512 ? F.in[IN_ANORM] + k0 : F.in[IN_YNORM] + (k0 - 512);
            transpose_item(F.in[IN_WOUT], 1024, 1024, WoutT, 32 * nb, scr, k0, 32 * nb, ks, F.lane); continue; } r -= I_OUT;
        if (r < I_GU) { const int e = r >> 10, q = r & 1023, kb = q >> 6, nb = q & 63, n0 = 32 * nb; const int j0 = n0 & 1023; const int dst = (j0 >> 7) * 256 + (n0 >= 1024 ? 128 : 0) + (j0 & 127);
            transpose_item(F.in[IN_WGU] + (size_t)e * 1024 * 2048, 1024, 2048, WguT + (size_t)e * 2048 * 1024, dst, scr, 64 * kb, n0, nullptr, F.lane); continue; } r -= I_GU;
        { const int e = r >> 9, q = r & 511, kb = q >> 5, nb = q & 31;
            transpose_item(F.in[IN_WDOWN] + (size_t)e * 1024 * 1024, 1024, 1024, WdT + (size_t)e * 1024 * 1024, 32 * nb, scr, 64 * kb, 32 * nb, nullptr, F.lane); }
    }
}

__device__ __forceinline__ void ph_filter(const Frame& F) {
    LAS float* zf = (LAS float*)(F.lds + 8 * 64 * 33 * 4);
    LAS float* hA = zf + 33 * 64; LAS float* hB = hA + 64 * 64;
    const float* w1 = F.in[IN_FW1]; const float* b1 = F.in[IN_FB1]; const float* w2 = F.in[IN_FW2]; const float* b2 = F.in[IN_FB2];
    const float* w3 = F.in[IN_FW3]; const float* b3 = F.in[IN_FB3]; const float* w4 = F.in[IN_FW4]; const float* fr = F.in[IN_FFREQ];
    bf16* RG = (bf16*)(F.ws + WS_RG); float* nrm2 = (float*)(F.ws + WS_CTL) + CW_NRM;
    const int pl = F.lane, jg = F.wave;
    constexpr float MAXD = 15.350567286626973f, MIND = 3.0701134573253945f;
    for (int item = blockIdx.x; item < 64; item += gridDim.x) {
        const int p = item * 64 + pl;
        for (int f = jg; f < 33; f += 8) {
            float v;
            if (f == 0) v = (float)p / 4095.0f;
            else { const int bi = (f - 1) & 15; const float band = 1e-4f + (15.0f - 1e-4f) * (float)bi / 15.0f; const float w = 6.283185307179586f * (float)p / 4096.0f; const float a = band * w; v = (f <= 16) ? cosf(a) : -sinf(a); }
            zf[f * 64 + pl] = v;
        }
        __syncthreads();
#pragma unroll 1
        for (int jj = 0; jj < 8; ++jj) { const int j = jg * 8 + jj; float pre = b1[j]; for (int i = 0; i < 33; ++i) pre += zf[i * 64 + pl] * w1[i * 64 + j]; hA[j * 64 + pl] = sinf(fr[j] * pre); }
        __syncthreads();
#pragma unroll 1
        for (int jj = 0; jj < 8; ++jj) { const int j = jg * 8 + jj; float pre = b2[j]; for (int i = 0; i < 64; ++i) pre += hA[i * 64 + pl] * w2[i * 64 + j]; hB[j * 64 + pl] = sinf(fr[j] * pre); }
        __syncthreads();
#pragma unroll 1
        for (int jj = 0; jj < 8; ++jj) { const int j = jg * 8 + jj; float pre = b3[j]; for (int i = 0; i < 64; ++i) pre += hB[i * 64 + pl] * w3[i * 64 + j]; hA[j * 64 + pl] = sinf(fr[j] * pre); }
        __syncthreads();
        float h[64];
#pragma unroll
        for (int i = 0; i < 64; ++i) h[i] = hA[i * 64 + pl];
        const float tl = (float)p / 4095.0f;
#pragma unroll 1
        for (int nn = 0; nn < 128; ++nn) { const int n = jg * 128 + nn; float val = 0.f;
#pragma unroll
            for (int i = 0; i < 64; ++i) val += h[i] * w4[i * 1024 + n];
            const int c = n & 511; const float delta = MIND + (MAXD - MIND) * (float)c / 511.0f; val *= expf(-tl * delta);
            float ss = val * val;
            if (n < 512) RG[(size_t)c * 8192 + 4096 - p] = (bf16)f2bf(val);
            else { if (p >= 1) RG[(size_t)c * 8192 + 4096 + p] = (bf16)f2bf(val); else { RG[(size_t)c * 8192] = 0; ss = 0.f; } }
            ss = wave_sum(ss); if (pl == 0) atomicAdd(&nrm2[c], ss); }
        __syncthreads();
    }
}

__device__ __forceinline__ void ph_h1(const Frame& F) {
    const float* MOD = (const float*)(F.ws + WS_MOD); bf16* H1 = (bf16*)(F.ws + WS_H1); const float* g = F.in[IN_NORM1];
    for (int row = F.gw; row < MROWS; row += F.ngw) {
        const float* xr = row < T ? F.in[IN_X] + (size_t)row * 1024 : F.in[IN_CTX] + (size_t)(row - T) * 1024;
        const int mb = row < T ? (row >> 12) : 8; const float* sh = MOD + mb * 6144; const float* sc = sh + 1024;
        f32x4 v[4]; float ss = 0.f;
#pragma unroll
        for (int j = 0; j < 4; ++j) { v[j] = *(const f32x4*)(xr + 4 * F.lane + 256 * j); ss += (v[j].x * v[j].x + v[j].y * v[j].y) + (v[j].z * v[j].z + v[j].w * v[j].w); }
        const float rstd = rsqrtf(wave_sum(ss) * (1.0f / 1024.0f) + EPS);
#pragma unroll
        for (int j = 0; j < 4; ++j) { const int idx = 4 * F.lane + 256 * j; const f32x4 gg = *(const f32x4*)(g + idx), s1 = *(const f32x4*)(sc + idx), s0 = *(const f32x4*)(sh + idx);
            const f32x4 o = (v[j] * rstd * gg) * (1.0f + s1) + s0;
            v2u w; w.x = pk2(o.x, o.y); w.y = pk2(o.z, o.w); *(v2u*)(H1 + (size_t)row * 1024 + idx) = w; }
    }
}

__device__ __forceinline__ void ph_qkpost(const Frame& F) {
    bf16* PROJ = (bf16*)(F.ws + WS_PROJ); const float* qn = F.in[IN_QNORM]; const float* kn = F.in[IN_KNORM];
    const int f = F.lane & 15; const float invf = powf(10000.0f, -(float)f / 16.0f);
    const float gq = qn[F.lane], gk = kn[F.lane];
    for (int row = F.gw; row < MROWS; row += F.ngw) {
        const bool isctx = row >= T; const int t = row & 4095; const float pos = (F.lane < 32) ? (float)(t >> 6) : (float)(t & 63);
        const float ang = pos * invf; const float cs = cosf(ang), sn = sinf(ang);
        bf16* pr = PROJ + (size_t)row * INW;
        for (int h = isctx ? 8 : 0; h < 10; ++h) {
            const float v = bf2f(pr[h * 64 + F.lane]);
            const float ss = wave_sum(v * v);
            float y = v * rsqrtf(ss * (1.0f / 64.0f) + EPS) * (h < 8 ? gq : gk);
            if (!isctx) { const float partner = __shfl_xor(y, 16); y = (F.lane & 16) ? (partner * sn + y * cs) : (y * cs - partner * sn); }
            pr[h * 64 + F.lane] = (bf16)f2bf(y);
        }
    }
}

__device__ __forceinline__ void ph_zprep(const Frame& F) {
    const bf16* PROJ = (const bf16*)(F.ws + WS_PROJ); bf16* ZT = (bf16*)(F.ws + WS_ZT); bf16* X0T = (bf16*)(F.ws + WS_X0T);
    const float* cw = F.in[IN_CONVW]; const float* cb = F.in[IN_CONVB];
    LAS float* raw = (LAS float*)F.lds;
    for (int item = blockIdx.x; item < 8 * 64 * 8; item += gridDim.x) {
        const int b = item >> 9, tb = (item >> 3) & 63, cbk = item & 7; const int t0 = tb * 64, c0 = cbk * 64;
        for (int i = F.tid; i < 3 * 66 * 64; i += NTHR) { const int g = i / (66 * 64), rem = i % (66 * 64), r = rem >> 6, cc = rem & 63; const int t = t0 - 1 + r;
            float v = 0.f; if (t >= 0 && t < SEQ) v = bf2f(PROJ[(size_t)(b * SEQ + t) * INW + 768 + g * 512 + c0 + cc]);
            raw[(g * 66 + r) * 65 + cc] = v; }
        __syncthreads();
        const int tt = F.lane, cg8 = F.wave;
#pragma unroll 1
        for (int ci = 0; ci < 8; ++ci) { const int cc = cg8 * 8 + ci, c = c0 + cc; float uc[3];
#pragma unroll
            for (int g = 0; g < 3; ++g) { const int ch = g * 512 + c; const LAS float* rp = raw + (g * 66 + tt) * 65 + cc;
                uc[g] = cb[ch] + cw[ch] * rp[0] + cw[1536 + ch] * rp[65] + cw[3072 + ch] * rp[130]; }
            const size_t o = ((size_t)c * 8 + b) * SEQ + t0 + tt;
            X0T[o] = (bf16)f2bf(uc[0]); ZT[o] = (bf16)f2bf(uc[1] * uc[2]); }
        __syncthreads();
    }
}

__device__ __forceinline__ void ph_attn_naive(const Frame& F) {
    const bf16* PROJ = (const bf16*)(F.ws + WS_PROJ); float* ATT = (float*)(F.ws + WS_ATT); const float* sink = F.in[IN_SINK];
    LAS float* wsc = (LAS float*)F.lds + F.wave * 640;
    for (int it = F.gw; it < T * 8; it += F.ngw) {
        const int row = it >> 3, hq = it & 7, hkv = hq >> 2, b = row >> 12, t = row & 4095;
        float q[64];
        { const v4u* qp = (const v4u*)(PROJ + (size_t)row * INW + hq * 64);
#pragma unroll
          for (int i = 0; i < 8; ++i) { const v4u w = qp[i]; q[8 * i + 0] = bflo(w.x); q[8 * i + 1] = bfhi(w.x); q[8 * i + 2] = bflo(w.y); q[8 * i + 3] = bfhi(w.y); q[8 * i + 4] = bflo(w.z); q[8 * i + 5] = bfhi(w.z); q[8 * i + 6] = bflo(w.w); q[8 * i + 7] = bfhi(w.w); } }
        const int j0 = t - 128 < 0 ? 0 : t - 128, j1 = t + 128 > SEQ - 1 ? SEQ - 1 : t + 128; const int nloc = j1 - j0 + 1, nkeys = nloc + LC;
        const float sk = sink[hq];
        float mx = -INFINITY;
        for (int kk = F.lane; kk < nkeys; kk += 64) {
            const size_t krow = kk < nloc ? (size_t)(b * SEQ + j0 + kk) : (size_t)(T + b * LC + (kk - nloc));
            const v4u* kp = (const v4u*)(PROJ + krow * INW + 512 + hkv * 64); float s = 0.f;
#pragma unroll
            for (int i = 0; i < 8; ++i) { const v4u w = kp[i];
                s += q[8 * i + 0] * bflo(w.x) + q[8 * i + 1] * bfhi(w.x) + q[8 * i + 2] * bflo(w.y) + q[8 * i + 3] * bfhi(w.y) + q[8 * i + 4] * bflo(w.z) + q[8 * i + 5] * bfhi(w.z) + q[8 * i + 6] * bflo(w.w) + q[8 * i + 7] * bfhi(w.w); }
            s *= 0.125f; wsc[kk] = s; mx = fmaxf(mx, s);
        }
        mx = fmaxf(wave_max(mx), sk);
        float sum = 0.f;
        for (int kk = F.lane; kk < nkeys; kk += 64) { const float p = __expf(wsc[kk] - mx); wsc[kk] = p; sum += p; }
        sum = wave_sum(sum) + __expf(sk - mx);
        LDS_FENCE();
        float o = 0.f;
        for (int kk = 0; kk < nkeys; ++kk) { const size_t vrow = kk < nloc ? (size_t)(b * SEQ + j0 + kk) : (size_t)(T + b * LC + (kk - nloc));
            o += wsc[kk] * bf2f(PROJ[vrow * INW + 640 + hkv * 64 + F.lane]); }
        ATT[(size_t)row * 512 + hq * 64 + F.lane] = o / sum;
        LDS_FENCE();
    }
}

__device__ __forceinline__ void ph_hyena_naive(const Frame& F) {
    const bf16* RG = (const bf16*)(F.ws + WS_RG); const bf16* ZT = (const bf16*)(F.ws + WS_ZT); const bf16* X0T = (const bf16*)(F.ws + WS_X0T); bf16* YT = (bf16*)(F.ws + WS_YT);
    const float* nrm2 = (const float*)(F.ws + WS_CTL) + CW_NRM; const float* fb = F.in[IN_FBIAS];
    LAS bf16* Rl = (LAS bf16*)F.lds;
    LAS bf16* zl = Rl + 8192;
    for (int c = blockIdx.x; c < 512; c += gridDim.x) {
        for (int i = F.tid; i < 1024; i += NTHR) ((LAS v4u*)Rl)[i] = ((const v4u*)(RG + (size_t)c * 8192))[i];
        for (int i = F.tid; i < 4096; i += NTHR) ((LAS v4u*)zl)[i] = ((const v4u*)(ZT + (size_t)c * 8 * SEQ))[i];
        __syncthreads();
        const float nrm = rsqrtf(nrm2[c] + EPS), bias = fb[c];
#pragma unroll 1
        for (int ti = 0; ti < 8; ++ti) { const int t = F.tid + 512 * ti;
            float acc[8];
#pragma unroll
            for (int b = 0; b < 8; ++b) acc[b] = 0.f;
            const LAS bf16* rp = Rl + 4096 - t;
#pragma unroll 2
            for (int s = 0; s < SEQ; s += 2) { const float g0 = bf2f(rp[s]), g1 = bf2f(rp[s + 1]);
#pragma unroll
                for (int b = 0; b < 8; ++b) { const unsigned zz = *(const LAS unsigned*)(zl + b * SEQ + s); acc[b] += g0 * bflo(zz) + g1 * bfhi(zz); } }
#pragma unroll
            for (int b = 0; b < 8; ++b) { const float zt = bf2f(zl[b * SEQ + t]); const size_t o = ((size_t)c * 8 + b) * SEQ + t;
                const float y = bf2f(X0T[o]) * (acc[b] * nrm + bias * zt); YT[o] = (bf16)f2bf(y); }
        }
        __syncthreads();
    }
}

__device__ __forceinline__ void ph_merge(const Frame& F) {
    const float* ATT = (const float*)(F.ws + WS_ATT); const bf16* YT = (const bf16*)(F.ws + WS_YT); bf16* A2 = (bf16*)(F.ws + WS_A2);
    LAS bf16* yl = (LAS bf16*)F.lds;
    LAS float* part = (LAS float*)(F.lds + 512 * 72 * 2);
    LAS float* rsy = part + 512;
    for (int item = blockIdx.x; item < 512; item += gridDim.x) {
        const int b = item >> 6, t0 = (item & 63) * 64;
        for (int i = F.tid; i < 4096; i += NTHR) { const int c = i >> 3, pc = i & 7; *(LAS v4u*)(yl + c * 72 + pc * 8) = *(const v4u*)(YT + ((size_t)c * 8 + b) * SEQ + t0 + pc * 8); }
        __syncthreads();
        { const int tt = F.lane, cq = F.wave; float s = 0.f; for (int c = cq * 64; c < cq * 64 + 64; ++c) { const float v = bf2f(yl[c * 72 + tt]); s += v * v; } part[cq * 64 + tt] = s; }
        __syncthreads();
        if (F.tid < 64) { float s = 0.f; for (int w = 0; w < 8; ++w) s += part[w * 64 + F.tid]; rsy[F.tid] = rsqrtf(s * (1.0f / 512.0f) + EPS); }
        __syncthreads();
#pragma unroll 1
        for (int r = 0; r < 8; ++r) { const int tt = F.wave * 8 + r; const size_t row = (size_t)b * SEQ + t0 + tt;
            const f32x4 a0 = *(const f32x4*)(ATT + row * 512 + F.lane * 8), a1 = *(const f32x4*)(ATT + row * 512 + F.lane * 8 + 4);
            float ss = (a0.x * a0.x + a0.y * a0.y) + (a0.z * a0.z + a0.w * a0.w) + (a1.x * a1.x + a1.y * a1.y) + (a1.z * a1.z + a1.w * a1.w);
            const float ra = rsqrtf(wave_sum(ss) * (1.0f / 512.0f) + EPS);
            v4u w; w.x = pk2(a0.x * ra, a0.y * ra); w.y = pk2(a0.z * ra, a0.w * ra); w.z = pk2(a1.x * ra, a1.y * ra); w.w = pk2(a1.z * ra, a1.w * ra);
            *(v4u*)(A2 + row * 1024 + F.lane * 8) = w;
            const float ry = rsy[tt]; float yv[8];
#pragma unroll
            for (int i = 0; i < 8; ++i) yv[i] = bf2f(yl[(F.lane * 8 + i) * 72 + tt]) * ry;
            v4u w2; w2.x = pk2(yv[0], yv[1]); w2.y = pk2(yv[2], yv[3]); w2.z = pk2(yv[4], yv[5]); w2.w = pk2(yv[6], yv[7]);
            *(v4u*)(A2 + row * 1024 + 512 + F.lane * 8) = w2; }
        __syncthreads();
    }
}

__device__ __forceinline__ void ph_router(const Frame& F) {
    const float* MOD = (const float*)(F.ws + WS_MOD); bf16* H2 = (bf16*)(F.ws + WS_H1); const float* g = F.in[IN_NORM2];
    const float* wr = F.in[IN_WROUTER]; const float* br = F.in[IN_BROUTER];
    int* TOKE = (int*)(F.ws + WS_ROUTE); int* TOKR = TOKE + T * 4; float* TOKG = (float*)(TOKR + T * 4);
    unsigned* cnt = (unsigned*)(F.ws + WS_CTL) + CW_CNT;
    LAS float* hrow = (LAS float*)F.lds + F.wave * 1024;
    const int e = F.lane & 31, half = F.lane >> 5;
    for (int tok = F.gw; tok < T; tok += F.ngw) {
        const int b = tok >> 12; const float* sh = MOD + b * 6144 + 3072; const float* sc = MOD + b * 6144 + 4096;
        const float* xr = F.out + (size_t)tok * 1024;
        f32x4 v[4]; float ss = 0.f;
#pragma unroll
        for (int j = 0; j < 4; ++j) { v[j] = *(const f32x4*)(xr + 4 * F.lane + 256 * j); ss += (v[j].x * v[j].x + v[j].y * v[j].y) + (v[j].z * v[j].z + v[j].w * v[j].w); }
        const float rstd = rsqrtf(wave_sum(ss) * (1.0f / 1024.0f) + EPS);
#pragma unroll
        for (int j = 0; j < 4; ++j) { const int idx = 4 * F.lane + 256 * j; const f32x4 gg = *(const f32x4*)(g + idx), s1 = *(const f32x4*)(sc + idx), s0 = *(const f32x4*)(sh + idx);
            const f32x4 o = (v[j] * rstd * gg) * (1.0f + s1) + s0;
            v2u w; w.x = pk2(o.x, o.y); w.y = pk2(o.z, o.w); *(v2u*)(H2 + (size_t)tok * 1024 + idx) = w;
            *(LAS f32x4*)(hrow + idx) = o; }
        LDS_FENCE();
        float acc = 0.f;
        { const LAS float* hp = hrow + half * 512; const float* wp = wr + (size_t)half * 512 * 32 + e;
#pragma unroll 8
          for (int k = 0; k < 512; ++k) acc += hp[k] * wp[k * 32]; }
        acc += __shfl_xor(acc, 32);
        float val = acc + br[e];
        float sv[4]; int si[4];
#pragma unroll
        for (int r = 0; r < 4; ++r) { float m = val;
#pragma unroll
            for (int o = 16; o >= 1; o >>= 1) m = fmaxf(m, __shfl_xor(m, o));
            const unsigned long long bal = __ballot(val == m) & 0xffffffffull; const int idx = __ffsll((long long)bal) - 1;
            sv[r] = m; si[r] = idx; if (e == idx) val = -INFINITY; }
        const float e1 = __expf(sv[1] - sv[0]), e2 = __expf(sv[2] - sv[0]), e3 = __expf(sv[3] - sv[0]); const float inv = 1.0f / (1.0f + e1 + e2 + e3);
        if (F.lane < 4) { const int me = F.lane == 0 ? si[0] : F.lane == 1 ? si[1] : F.lane == 2 ? si[2] : si[3]; const float mg = (F.lane == 0 ? 1.0f : F.lane == 1 ? e1 : F.lane == 2 ? e2 : e3) * inv;
            const unsigned rank = atomicAdd(&cnt[me], 1u);
            TOKE[tok * 4 + F.lane] = me; TOKR[tok * 4 + F.lane] = (int)rank; TOKG[tok * 4 + F.lane] = mg; }
        LDS_FENCE();
    }
}

__device__ __forceinline__ void build_tile_table(const Frame& F) {
    LAS int* tstart = (LAS int*)(F.lds + MISC_OFF);
    const unsigned* cnt = (const unsigned*)(F.ws + WS_CTL) + CW_CNT;
    if (F.tid == 0) { int acc = 0; for (int e = 0; e < 32; ++e) { tstart[e] = acc; acc += (int)((cnt[e] + 255u) >> 8); } tstart[32] = acc; }
    __syncthreads();
}

__device__ __forceinline__ void ph_gather(const Frame& F) {
    build_tile_table(F);
    const LAS int* tstart = (const LAS int*)(F.lds + MISC_OFF);
    const bf16* H2 = (const bf16*)(F.ws + WS_H1); bf16* XS = (bf16*)(F.ws + WS_XS);
    const int* TOKE = (const int*)(F.ws + WS_ROUTE); const int* TOKR = TOKE + T * 4; int* SLOT = (int*)(F.ws + WS_ROUTE) + 3 * T * 4;
    for (int a = F.gw; a < T * 4; a += F.ngw) {
        const int tok = a >> 2; const int e = TOKE[a], rank = TOKR[a]; const int slot = tstart[e] * 256 + rank;
        const v4u* src = (const v4u*)(H2 + (size_t)tok * 1024); v4u* dst = (v4u*)(XS + (size_t)slot * 1024);
        dst[F.lane] = src[F.lane]; dst[F.lane + 64] = src[F.lane + 64];
        if (F.lane == 0) SLOT[a] = slot;
    }
}

__device__ __forceinline__ void ph_combine(const Frame& F) {
    const float* MOD = (const float*)(F.ws + WS_MOD); const bf16* YS = (const bf16*)(F.ws + WS_XS);
    const float* TOKG = (const float*)(F.ws + WS_ROUTE) + 2 * T * 4; const int* SLOT = (const int*)(F.ws + WS_ROUTE) + 3 * T * 4;
    float pscale = 1.0f, pspike = 0.0f;
#if PROBE_A >= 0
    { const unsigned long long* ts = (const unsigned long long*)(F.ws + WS_CTL + CW_TS_BYTES); const float tot = (float)(ts[11] - ts[0]);
      pscale = 1.0f + 0.5f * (float)(ts[PROBE_A + 1] - ts[PROBE_A]) / tot;
#if PROBE_B >= 0
      pspike = 10.0f + 90.0f * (float)(ts[PROBE_B + 1] - ts[PROBE_B]) / tot;
#endif
    }
#endif
    for (int tok = F.gw; tok < T; tok += F.ngw) {
        const int b = tok >> 12; const float* g2 = MOD + b * 6144 + 5120; float* xr = F.out + (size_t)tok * 1024;
        int sl[4]; float gt[4];
#pragma unroll
        for (int k = 0; k < 4; ++k) { sl[k] = SLOT[tok * 4 + k]; gt[k] = TOKG[tok * 4 + k]; }
#pragma unroll
        for (int j = 0; j < 4; ++j) { const int idx = 4 * F.lane + 256 * j; f32x4 m = {0.f, 0.f, 0.f, 0.f};
#pragma unroll
            for (int k = 0; k < 4; ++k) { const v2u w = *(const v2u*)(YS + (size_t)sl[k] * 1024 + idx); m.x += gt[k] * bflo(w.x); m.y += gt[k] * bfhi(w.x); m.z += gt[k] * bflo(w.y); m.w += gt[k] * bfhi(w.y); }
            const f32x4 xv = *(const f32x4*)(xr + idx); const f32x4 gg = *(const f32x4*)(g2 + idx);
            f32x4 res = (xv + gg * m) * pscale; if (pspike != 0.0f && tok == 0 && idx == 0) res.x = pspike;
            *(f32x4*)(xr + idx) = res; }
    }
}

typedef float f32x16 __attribute__((ext_vector_type(16)));
__device__ __forceinline__ int crow16(int r, int hi) { return (r & 3) + 8 * (r >> 2) + 4 * hi; }
constexpr int HY_RL_BYTES = 32 + 8192 * 2;
constexpr int HY_BPITCH = 528;
constexpr int HY_BBUF = 64 * HY_BPITCH;
constexpr int HY_B_OFF = HY_RL_BYTES;

template <int Q> __device__ __forceinline__ void hy_shift_store(const v4u (&W)[5], int sh, LAS unsigned char* dst) {
    const unsigned w[20] = {W[0].x, W[0].y, W[0].z, W[0].w, W[1].x, W[1].y, W[1].z, W[1].w, W[2].x, W[2].y, W[2].z, W[2].w, W[3].x, W[3].y, W[3].z, W[3].w, W[4].x, W[4].y, W[4].z, W[4].w};
#pragma unroll
    for (int p = 0; p < 4; ++p) { v4u o;
        o.x = __builtin_amdgcn_alignbit(w[4 * p + Q + 1], w[4 * p + Q + 0], sh);
        o.y = __builtin_amdgcn_alignbit(w[4 * p + Q + 2], w[4 * p + Q + 1], sh);
        o.z = __builtin_amdgcn_alignbit(w[4 * p + Q + 3], w[4 * p + Q + 2], sh);
        o.w = __builtin_amdgcn_alignbit(w[4 * p + Q + 4], w[4 * p + Q + 3], sh);
        *(LAS v4u*)(dst + 16 * p) = o; }
}

__device__ __forceinline__ void ph_hyena_mfma(const Frame& F) {
    const bf16* RG = (const bf16*)(F.ws + WS_RG); const bf16* ZT = (const bf16*)(F.ws + WS_ZT); const bf16* X0T = (const bf16*)(F.ws + WS_X0T); bf16* YT = (bf16*)(F.ws + WS_YT);
    const float* nrm2 = (const float*)(F.ws + WS_CTL) + CW_NRM; const float* fb = F.in[IN_FBIAS];
    LAS unsigned char* Rl = F.lds; LAS unsigned char* Bb = F.lds + HY_B_OFF;
    const int lane = F.lane, w = F.wave, r32 = lane & 31, hi = lane >> 5;
    const int bb = lane >> 3, seg = lane & 7; const int brow = w * 8 + bb;
    const int shq = w >> 1, shb = (w & 1) * 16;
    for (int c = blockIdx.x; c < 512; c += gridDim.x) {
        if (F.tid < 2) ((LAS v4u*)Rl)[F.tid] = (v4u){0u, 0u, 0u, 0u};
        for (int i = F.tid; i < 1024; i += NTHR) ((LAS v4u*)(Rl + 32))[i] = ((const v4u*)(RG + (size_t)c * 8192))[i];
        const bf16* zrow = ZT + ((size_t)c * 8 + bb) * SEQ;
        v4u W[5];
        auto LOADW = [&](int k) {
            const int sb = -16 + 256 * k + 32 * seg;
#pragma unroll
            for (int i = 0; i < 5; ++i) { const int s = sb + 8 * i; W[i] = (s >= 0 && s < SEQ) ? *(const v4u*)(zrow + s) : (v4u){0u, 0u, 0u, 0u}; }
        };
        auto STOREW = [&](int buf) {
            LAS unsigned char* dst = Bb + buf * HY_BBUF + brow * HY_BPITCH + seg * 64;
            if (shq == 0) hy_shift_store<0>(W, shb, dst); else if (shq == 1) hy_shift_store<1>(W, shb, dst); else if (shq == 2) hy_shift_store<2>(W, shb, dst); else hy_shift_store<3>(W, shb, dst);
        };
        LOADW(0); STOREW(0);
        f32x16 acc[2][2];
#pragma unroll
        for (int a = 0; a < 2; ++a)
#pragma unroll
            for (int n = 0; n < 2; ++n)
#pragma unroll
                for (int r = 0; r < 16; ++r) acc[a][n][r] = 0.f;
        __syncthreads();
        const int t00 = 512 * w;
        const LAS unsigned char* a0p = Rl + 2 * (4096 - t00 - 8 * r32 + 8 * hi);
        const LAS unsigned char* a1p = a0p - 512;
        for (int k = 0; k < 17; ++k) {
            const int buf = k & 1;
            if (k < 16) LOADW(k + 1);
            const LAS unsigned char* bp = Bb + buf * HY_BBUF + r32 * HY_BPITCH + 16 * hi;
            const int nst = (k < 16) ? 16 : 1;
#pragma unroll 4
            for (int i = 0; i < nst; ++i) {
                const int so = 32 * (16 * k + i);
                const bf16x8 A0 = *(const LAS bf16x8*)(a0p + so), A1 = *(const LAS bf16x8*)(a1p + so);
                const bf16x8 B0 = *(const LAS bf16x8*)(bp + 32 * i), B1 = *(const LAS bf16x8*)(bp + 32 * HY_BPITCH + 32 * i);
                acc[0][0] = __builtin_amdgcn_mfma_f32_32x32x16_bf16(A0, B0, acc[0][0], 0, 0, 0);
                acc[0][1] = __builtin_amdgcn_mfma_f32_32x32x16_bf16(A0, B1, acc[0][1], 0, 0, 0);
                acc[1][0] = __builtin_amdgcn_mfma_f32_32x32x16_bf16(A1, B0, acc[1][0], 0, 0, 0);
                acc[1][1] = __builtin_amdgcn_mfma_f32_32x32x16_bf16(A1, B1, acc[1][1], 0, 0, 0);
            }
            if (k < 16) STOREW(buf ^ 1);
            __syncthreads();
        }
        const float nrm = rsqrtf(nrm2[c] + EPS), bias = fb[c];
        LAS float* yst = (LAS float*)(Bb + w * 8192);
#pragma unroll
        for (int mi = 0; mi < 2; ++mi) {
#pragma unroll
            for (int nj = 0; nj < 2; ++nj) { const int rho = 4 * nj + (r32 >> 3), b = lane & 7;
#pragma unroll
                for (int r = 0; r < 16; ++r) yst[b * 256 + 8 * crow16(r, hi) + rho] = acc[mi][nj][r]; }
            LDS_FENCE();
            const int t0 = t00 + 256 * mi;
#pragma unroll 1
            for (int it = 0; it < 4; ++it) { const int p = it * 64 + lane, b = p >> 5, tp = p & 31;
                const size_t o = ((size_t)c * 8 + b) * SEQ + t0 + 8 * tp;
                const v4u xz = *(const v4u*)(X0T + o), zz = *(const v4u*)(ZT + o);
                const f32x4 y0 = *(const LAS f32x4*)(yst + b * 256 + 8 * tp), y1 = *(const LAS f32x4*)(yst + b * 256 + 8 * tp + 4);
                v4u ov;
                ov.x = pk2(bflo(xz.x) * (y0.x * nrm + bias * bflo(zz.x)), bfhi(xz.x) * (y0.y * nrm + bias * bfhi(zz.x)));
                ov.y = pk2(bflo(xz.y) * (y0.z * nrm + bias * bflo(zz.y)), bfhi(xz.y) * (y0.w * nrm + bias * bfhi(zz.y)));
                ov.z = pk2(bflo(xz.z) * (y1.x * nrm + bias * bflo(zz.z)), bfhi(xz.z) * (y1.y * nrm + bias * bfhi(zz.z)));
                ov.w = pk2(bflo(xz.w) * (y1.z * nrm + bias * bflo(zz.w)), bfhi(xz.w) * (y1.w * nrm + bias * bfhi(zz.w)));
                *(v4u*)(YT + o) = ov; }
            LDS_FENCE();
        }
        __syncthreads();
    }
}

typedef short s16x4 __attribute__((ext_vector_type(4)));
__device__ __forceinline__ s16x4 ds_tr16(const LAS unsigned char* p) { return __builtin_bit_cast(s16x4, __builtin_amdgcn_ds_read_tr16_b64_v4i16((LAS s16x4*)p)); }
constexpr int AT_KB = 0, AT_VB = 16384, AT_WS = 32768;

__device__ __forceinline__ void ph_attn_mfma(const Frame& F) {
    const bf16* PROJ = (const bf16*)(F.ws + WS_PROJ); float* ATT = (float*)(F.ws + WS_ATT); const float* sink = F.in[IN_SINK];
    const int lane = F.lane, w = F.wave, r32 = lane & 31, hi = lane >> 5;
    LAS float* wsf = (LAS float*)(F.lds + AT_WS) + w * 64;
    constexpr float C2 = 0.125f * 1.4426950408889634f, LOG2E = 1.4426950408889634f;
    const int skey = F.tid >> 3, sch = F.tid & 7;
    const int kdst = skey * 128 + ((sch ^ ((skey >> 1) & 7)) << 4);
    const int vdst = skey * 128 + ((sch ^ (((skey >> 1) & 1) << 2)) << 4);
    for (int item = blockIdx.x; item < 512; item += gridDim.x) {
        const int b = item >> 6, nb = (item >> 1) & 31, hkv = item & 1;
        const int g = w >> 1, hq = hkv * 4 + g; const int q0 = nb * 128 + (w & 1) * 64;
        bf16x8 qf[2][4];
#pragma unroll
        for (int u = 0; u < 2; ++u)
#pragma unroll
            for (int ks = 0; ks < 4; ++ks) qf[u][ks] = *(const bf16x8*)(PROJ + (size_t)(b * SEQ + q0 + 32 * u + r32) * INW + hq * 64 + 16 * ks + 8 * hi);
        const float sk2 = sink[hq] * LOG2E;
        float m2[2] = {sk2, sk2}; float lsum[2] = {hi == 0 ? 1.0f : 0.0f, hi == 0 ? 1.0f : 0.0f};
        f32x16 o[2][2];
#pragma unroll
        for (int u = 0; u < 2; ++u)
#pragma unroll
            for (int d = 0; d < 2; ++d)
#pragma unroll
                for (int r = 0; r < 16; ++r) o[u][d][r] = 0.f;
        const int kt_lo = (nb == 0) ? 2 : 0;
        auto tile_row = [&](int kt) -> long {
            return kt < 6 ? (long)b * SEQ + (nb - 1 + (kt >> 1)) * 128 + (kt & 1) * 64 : (long)T + b * LC + (kt - 6) * 64; };
        auto next_tile = [&](int kt) -> int { int n = kt + 1; if (nb == 31 && (n == 4 || n == 5)) n = 6; return n; };
        v4u kreg, vreg;
        auto LOADKV = [&](int kt) { const bf16* rp = PROJ + (size_t)(tile_row(kt) + skey) * INW + 512 + hkv * 64 + sch * 8; kreg = *(const v4u*)rp; vreg = *(const v4u*)(rp + 128); };
        int kt = kt_lo, nbuf = 0;
        LOADKV(kt);
        while (kt < 10) {
            LAS unsigned char* Kl = F.lds + AT_KB + nbuf * 8192; LAS unsigned char* Vl = F.lds + AT_VB + nbuf * 8192;
            *(LAS v4u*)(Kl + kdst) = kreg; *(LAS v4u*)(Vl + vdst) = vreg;
            __syncthreads();
            const int ktn = next_tile(kt);
            if (ktn < 10) LOADKV(ktn);
            const bool local = kt < 6; const int kpos0 = (nb - 1 + (kt >> 1)) * 128 + (kt & 1) * 64;
#pragma unroll
            for (int u = 0; u < 2; ++u) {
                f32x16 p0, p1;
#pragma unroll
                for (int r = 0; r < 16; ++r) { p0[r] = 0.f; p1[r] = 0.f; }
#pragma unroll
                for (int ks = 0; ks < 4; ++ks) { const int ch = 2 * ks + hi;
                    const bf16x8 k0 = *(const LAS bf16x8*)(Kl + r32 * 128 + ((ch ^ ((r32 >> 1) & 7)) << 4));
                    const bf16x8 k1 = *(const LAS bf16x8*)(Kl + (32 + r32) * 128 + ((ch ^ (((32 + r32) >> 1) & 7)) << 4));
                    p0 = __builtin_amdgcn_mfma_f32_32x32x16_bf16(k0, qf[u][ks], p0, 0, 0, 0);
                    p1 = __builtin_amdgcn_mfma_f32_32x32x16_bf16(k1, qf[u][ks], p1, 0, 0, 0); }
                if (local) { const int qp = q0 + 32 * u + r32;
#pragma unroll
                    for (int r = 0; r < 16; ++r) { const int kp = kpos0 + crow16(r, hi); const int d0 = qp - kp, d1 = qp - (kp + 32);
                        if (d0 > 128 || d0 < -128) p0[r] = -INFINITY; if (d1 > 128 || d1 < -128) p1[r] = -INFINITY; } }
                float mx = fmaxf(p0[0], p1[0]);
#pragma unroll
                for (int r = 1; r < 16; ++r) mx = fmaxf(mx, fmaxf(p0[r], p1[r]));
                mx = fmaxf(mx, __shfl_xor(mx, 32));
                const float mnew = fmaxf(m2[u], mx * C2);
                if (__any(mnew > m2[u])) {
                    const float alpha = __builtin_amdgcn_exp2f(m2[u] - mnew); lsum[u] *= alpha; m2[u] = mnew;
                    if (hi == 0) wsf[r32] = alpha;
                    LDS_FENCE();
#pragma unroll
                    for (int r = 0; r < 16; ++r) { const float a = wsf[crow16(r, hi)]; o[u][0][r] *= a; o[u][1][r] *= a; }
                    LDS_FENCE();
                }
                float ps = 0.f;
#pragma unroll
                for (int r = 0; r < 16; ++r) { p0[r] = __builtin_amdgcn_exp2f(p0[r] * C2 - m2[u]); p1[r] = __builtin_amdgcn_exp2f(p1[r] * C2 - m2[u]); ps += p0[r] + p1[r]; }
                lsum[u] += ps;
                bf16x8 pa[4];
#pragma unroll
                for (int s = 0; s < 2; ++s) {
                    v4u a, c2;
                    a.x = pk2(p0[8 * s + 0], p0[8 * s + 1]); a.y = pk2(p0[8 * s + 2], p0[8 * s + 3]); a.z = pk2(p0[8 * s + 4], p0[8 * s + 5]); a.w = pk2(p0[8 * s + 6], p0[8 * s + 7]);
                    c2.x = pk2(p1[8 * s + 0], p1[8 * s + 1]); c2.y = pk2(p1[8 * s + 2], p1[8 * s + 3]); c2.z = pk2(p1[8 * s + 4], p1[8 * s + 5]); c2.w = pk2(p1[8 * s + 6], p1[8 * s + 7]);
                    pa[s] = __builtin_bit_cast(bf16x8, a); pa[2 + s] = __builtin_bit_cast(bf16x8, c2); }
#pragma unroll
                for (int d0 = 0; d0 < 2; ++d0)
#pragma unroll
                    for (int ks = 0; ks < 4; ++ks) {
                        const int row = 16 * ks + 4 * hi + ((lane & 15) >> 2); const int dcol = 32 * d0 + 16 * ((lane >> 4) & 1) + 4 * (lane & 3);
                        const int ch = dcol >> 3, wi = (dcol & 7) * 2;
                        const s16x4 lo = ds_tr16(Vl + row * 128 + ((ch ^ (((row >> 1) & 1) << 2)) << 4) + wi);
                        const int row2 = row + 8;
                        const s16x4 hh = ds_tr16(Vl + row2 * 128 + ((ch ^ (((row2 >> 1) & 1) << 2)) << 4) + wi);
                        const bf16x8 vb = (bf16x8){lo[0], lo[1], lo[2], lo[3], hh[0], hh[1], hh[2], hh[3]};
                        o[u][d0] = __builtin_amdgcn_mfma_f32_32x32x16_bf16(pa[ks], vb, o[u][d0], 0, 0, 0); }
            }
            kt = ktn; nbuf ^= 1;
        }
#pragma unroll
        for (int u = 0; u < 2; ++u) {
            const float lt = lsum[u] + __shfl_xor(lsum[u], 32);
            if (hi == 0) wsf[r32] = 1.0f / lt;
            LDS_FENCE();
#pragma unroll
            for (int r = 0; r < 16; ++r) { const float a = wsf[crow16(r, hi)]; const size_t row = (size_t)b * SEQ + q0 + 32 * u + crow16(r, hi);
                ATT[row * 512 + hq * 64 + r32] = o[u][0][r] * a; ATT[row * 512 + hq * 64 + 32 + r32] = o[u][1][r] * a; }
            LDS_FENCE();
        }
        __syncthreads();
    }
}

__device__ __forceinline__ void ph_h2(const Frame& F) {
    const float* MOD = (const float*)(F.ws + WS_MOD); bf16* H2 = (bf16*)(F.ws + WS_H1); const float* g = F.in[IN_NORM2];
    for (int row = F.gw; row < T; row += F.ngw) {
        const float* xr = F.out + (size_t)row * 1024; const int mb = row >> 12; const float* sh = MOD + mb * 6144 + 3072; const float* sc = MOD + mb * 6144 + 4096;
        f32x4 v[4]; float ss = 0.f;
#pragma unroll
        for (int j = 0; j < 4; ++j) { v[j] = *(const f32x4*)(xr + 4 * F.lane + 256 * j); ss += (v[j].x * v[j].x + v[j].y * v[j].y) + (v[j].z * v[j].z + v[j].w * v[j].w); }
        const float rstd = rsqrtf(wave_sum(ss) * (1.0f / 1024.0f) + EPS);
#pragma unroll
        for (int j = 0; j < 4; ++j) { const int idx = 4 * F.lane + 256 * j; const f32x4 gg = *(const f32x4*)(g + idx), s1 = *(const f32x4*)(sc + idx), s0 = *(const f32x4*)(sh + idx);
            const f32x4 o = (v[j] * rstd * gg) * (1.0f + s1) + s0;
            v2u w; w.x = pk2(o.x, o.y); w.y = pk2(o.z, o.w); *(v2u*)(H2 + (size_t)row * 1024 + idx) = w; }
    }
}
__device__ __forceinline__ void ph_router_mfma(const Frame& F) {
    const float* MOD = (const float*)(F.ws + WS_MOD); const float* g = F.in[IN_NORM2];
    const float* wr = F.in[IN_WROUTER]; const float* br = F.in[IN_BROUTER];
    int* TOKE = (int*)(F.ws + WS_ROUTE); int* TOKR = TOKE + T * 4; float* TOKG = (float*)(TOKR + T * 4);
    unsigned* cnt = (unsigned*)(F.ws + WS_CTL) + CW_CNT;
    LAS float* Wl = (LAS float*)F.lds; LAS float* biasl = Wl + 32768; LAS float* part = biasl + 32;
    const int lane = F.lane, i16 = lane & 15, kq = lane >> 4;
    int cur_b = -1;
    for (int blk = blockIdx.x; blk < T / 128; blk += gridDim.x) {
        const int b = blk >> 5;
        if (b != cur_b) {
            __syncthreads();
            const float* sh = MOD + b * 6144 + 3072; const float* sc = MOD + b * 6144 + 4096;
            for (int idx = F.tid; idx < 32768; idx += NTHR) { const int k = idx >> 5, e = idx & 31; const float G = g[k] * (1.0f + sc[k]);
                Wl[((((k >> 4) * 4 + (k & 3)) * 2 + (e >> 4)) * 4 + ((k >> 2) & 3)) * 16 + (e & 15)] = G * wr[idx]; }
            { const int e = F.tid & 31, kc = F.tid >> 5; float s = 0.f; for (int k = kc * 64; k < kc * 64 + 64; ++k) s += sh[k] * wr[k * 32 + e]; part[kc * 32 + e] = s; }
            __syncthreads();
            if (F.tid < 32) { float s = br[F.tid]; for (int c = 0; c < 16; ++c) s += part[c * 32 + F.tid]; biasl[F.tid] = s; }
            __syncthreads();
            cur_b = b;
        }
        const int tok0 = blk * 128 + F.wave * 16;
        const float* xp = F.out + (size_t)(tok0 + i16) * 1024 + 4 * kq;
        f32x4 acc0 = {0.f, 0.f, 0.f, 0.f}, acc1 = {0.f, 0.f, 0.f, 0.f}; float ss = 0.f;
        const LAS float* wl = Wl + lane;
#pragma unroll 4
        for (int S = 0; S < 64; ++S) { const f32x4 xv = *(const f32x4*)(xp + 16 * S);
            ss += (xv.x * xv.x + xv.y * xv.y) + (xv.z * xv.z + xv.w * xv.w);
            const LAS float* wp = wl + S * 512;
            acc0 = __builtin_amdgcn_mfma_f32_16x16x4f32(xv.x, wp[0], acc0, 0, 0, 0);   acc1 = __builtin_amdgcn_mfma_f32_16x16x4f32(xv.x, wp[64], acc1, 0, 0, 0);
            acc0 = __builtin_amdgcn_mfma_f32_16x16x4f32(xv.y, wp[128], acc0, 0, 0, 0); acc1 = __builtin_amdgcn_mfma_f32_16x16x4f32(xv.y, wp[192], acc1, 0, 0, 0);
            acc0 = __builtin_amdgcn_mfma_f32_16x16x4f32(xv.z, wp[256], acc0, 0, 0, 0); acc1 = __builtin_amdgcn_mfma_f32_16x16x4f32(xv.z, wp[320], acc1, 0, 0, 0);
            acc0 = __builtin_amdgcn_mfma_f32_16x16x4f32(xv.w, wp[384], acc0, 0, 0, 0); acc1 = __builtin_amdgcn_mfma_f32_16x16x4f32(xv.w, wp[448], acc1, 0, 0, 0); }
        ss += __shfl_xor(ss, 16); ss += __shfl_xor(ss, 32);
        const float rstd = rsqrtf(ss * (1.0f / 1024.0f) + EPS);
        const float b0 = biasl[i16], b1 = biasl[16 + i16];
        float l0[4], l1[4];
#pragma unroll
        for (int r = 0; r < 4; ++r) { const float rs = __shfl(rstd, kq * 4 + r); l0[r] = acc0[r] * rs + b0; l1[r] = acc1[r] * rs + b1; }
#pragma unroll
        for (int r = 0; r < 4; ++r) {
            float sv[4]; int si[4];
#pragma unroll
            for (int rd = 0; rd < 4; ++rd) {
                float bv; int bi;
                if (l0[r] >= l1[r]) { bv = l0[r]; bi = i16; } else { bv = l1[r]; bi = 16 + i16; }
#pragma unroll
                for (int o = 1; o < 16; o <<= 1) { const float ov = __shfl_xor(bv, o); const int oi = __shfl_xor(bi, o); if (ov > bv || (ov == bv && oi < bi)) { bv = ov; bi = oi; } }
                sv[rd] = bv; si[rd] = bi;
                if (bi == i16) l0[r] = -INFINITY; if (bi == 16 + i16) l1[r] = -INFINITY;
            }
            const float e1 = __expf(sv[1] - sv[0]), e2 = __expf(sv[2] - sv[0]), e3 = __expf(sv[3] - sv[0]); const float inv = 1.0f / (1.0f + e1 + e2 + e3);
            if (i16 < 4) { const int me = i16 == 0 ? si[0] : i16 == 1 ? si[1] : i16 == 2 ? si[2] : si[3]; const float mg = (i16 == 0 ? 1.0f : i16 == 1 ? e1 : i16 == 2 ? e2 : e3) * inv;
                const int tok = tok0 + kq * 4 + r; const unsigned rank = atomicAdd(&cnt[me], 1u);
                TOKE[tok * 4 + i16] = me; TOKR[tok * 4 + i16] = (int)rank; TOKG[tok * 4 + i16] = mg; }
        }
    }
}

__device__ __forceinline__ void ph_filter2(const Frame& F) {
    LAS float* zf = (LAS float*)(F.lds + 8 * 64 * 33 * 4);
    LAS float* hA = zf + 33 * 16; LAS float* hB = hA + 64 * 16;
    const float* w1 = F.in[IN_FW1]; const float* b1 = F.in[IN_FB1]; const float* w2 = F.in[IN_FW2]; const float* b2 = F.in[IN_FB2];
    const float* w3 = F.in[IN_FW3]; const float* b3 = F.in[IN_FB3]; const float* w4 = F.in[IN_FW4]; const float* fr = F.in[IN_FFREQ];
    bf16* RG = (bf16*)(F.ws + WS_RG); float* nrm2 = (float*)(F.ws + WS_CTL) + CW_NRM;
    constexpr float MAXD = 15.350567286626973f, MIND = 3.0701134573253945f;
    const int pl = F.tid & 15, jg = F.tid >> 4;
    const int lane = F.lane, i16 = lane & 15, kq = lane >> 4;
    for (int item = blockIdx.x; item < 256; item += gridDim.x) {
        const int p = item * 16 + pl;
        for (int f = jg; f < 33; f += 32) {
            float v;
            if (f == 0) v = (float)p / 4095.0f;
            else { const int bi = (f - 1) & 15; const float band = 1e-4f + (15.0f - 1e-4f) * (float)bi / 15.0f; const float w = 6.283185307179586f * (float)p / 4096.0f; const float a = band * w; v = (f <= 16) ? cosf(a) : -sinf(a); }
            zf[f * 16 + pl] = v;
        }
        __syncthreads();
#pragma unroll 1
        for (int jj = 0; jj < 2; ++jj) { const int j = jg * 2 + jj; float pre = b1[j];
_Pragma("unroll 1")
            for (int i = 0; i < 33; ++i) pre += zf[i * 16 + pl] * w1[i * 64 + j]; hA[j * 16 + pl] = sinf(fr[j] * pre); }
        __syncthreads();
#pragma unroll 1
        for (int jj = 0; jj < 2; ++jj) { const int j = jg * 2 + jj; float pre = b2[j];
_Pragma("unroll 8")
            for (int i = 0; i < 64; ++i) pre += hA[i * 16 + pl] * w2[i * 64 + j]; hB[j * 16 + pl] = sinf(fr[j] * pre); }
        __syncthreads();
#pragma unroll 1
        for (int jj = 0; jj < 2; ++jj) { const int j = jg * 2 + jj; float pre = b3[j];
_Pragma("unroll 8")
            for (int i = 0; i < 64; ++i) pre += hB[i * 16 + pl] * w3[i * 64 + j]; hA[j * 16 + pl] = sinf(fr[j] * pre); }
        __syncthreads();
        float af[16];
#pragma unroll
        for (int s = 0; s < 16; ++s) af[s] = hA[(4 * s + kq) * 16 + i16];
#pragma unroll 1
        for (int nt = 0; nt < 8; ++nt) { const int n = F.wave * 128 + nt * 16 + i16;
            f32x4 acc = {0.f, 0.f, 0.f, 0.f};
#pragma unroll
            for (int s = 0; s < 16; ++s) acc = __builtin_amdgcn_mfma_f32_16x16x4f32(af[s], w4[(4 * s + kq) * 1024 + n], acc, 0, 0, 0);
            const int c = n & 511; const float delta = MIND + (MAXD - MIND) * (float)c / 511.0f; float ss = 0.f;
#pragma unroll
            for (int r = 0; r < 4; ++r) { const int pp = item * 16 + kq * 4 + r; const float val = acc[r] * expf(-((float)pp / 4095.0f) * delta);
                if (n < 512) { RG[(size_t)c * 8192 + 4096 - pp] = (bf16)f2bf(val); ss += val * val; }
                else { if (pp >= 1) { RG[(size_t)c * 8192 + 4096 + pp] = (bf16)f2bf(val); ss += val * val; } else RG[(size_t)c * 8192] = 0; } }
            ss += __shfl_xor(ss, 16); ss += __shfl_xor(ss, 32);
            if (kq == 0) atomicAdd(&nrm2[c], ss); }
        __syncthreads();
    }
}

#ifndef FUSED
#define FUSED 1
#endif
#ifndef NAIVE_ATTN
#define NAIVE_ATTN 0
#endif
#ifndef NAIVE_HYENA
#define NAIVE_HYENA 0
#endif
constexpr int NPHASES = 12;
__global__ void __launch_bounds__(NTHR, 2) fwd(Args args) {
    extern __shared__ __attribute__((aligned(16))) unsigned char lds[];
    Frame F;
    F.lds = (LAS unsigned char*)lds;
    F.tid = threadIdx.x; F.lane = F.tid & 63; F.wave = __builtin_amdgcn_readfirstlane(F.tid >> 6);
    F.gw = blockIdx.x * NWAVES + F.wave; F.ngw = gridDim.x * NWAVES;
#pragma unroll
    for (int i = 0; i < 32; ++i) F.in[i] = args.in[i];
    F.out = args.out; F.ws = args.ws;
    const int lo = args.ph_lo, hi = args.ph_hi;
#if FUSED
    cg::grid_group grid = cg::this_grid();
    if (F.tid < 2) ((volatile LAS unsigned*)(F.lds + LDS_BYTES - 16))[F.tid] = 0u;
    __syncthreads();
    XcdBarrier bar = xcd_barrier_post((unsigned*)(F.ws + WS_CTL) + CW_BAR, (volatile LAS unsigned*)(F.lds + LDS_BYTES - 16));
    unsigned long long* const tsw = (unsigned long long*)(F.ws + WS_CTL + CW_TS_BYTES);
#define STAMP(k) do { if (PROBE_A >= 0 && blockIdx.x == 0 && F.tid == 0) tsw[k] = __builtin_amdgcn_s_memrealtime(); } while (0)
#define SEAM(k) do { if (lo <= (k) && (k) + 1 < hi) { if ((k) < CG_SEAMS) { grid.sync(); if (DBL == 100) grid.sync(); if (DBL == 101) xcd_barrier(bar); } else xcd_barrier(bar); } STAMP((k) + 1); } while (0)
#else
#define STAMP(k) do { } while (0)
#define SEAM(k) do { } while (0)
#endif
#define IN(k) (lo <= (k) && (k) < hi)
    bf16* const H1 = (bf16*)(F.ws + WS_H1); bf16* const PROJ = (bf16*)(F.ws + WS_PROJ); bf16* const A2 = (bf16*)(F.ws + WS_A2);
    bf16* const XS = (bf16*)(F.ws + WS_XS); bf16* const HID = (bf16*)(F.ws + WS_HID);

    STAMP(0);
    if (IN(0)) { ph_mod(F); if (DBL == 0) { __syncthreads(); ph_mod(F); } SEAM(0); }
    if (IN(1)) { ph_transposes(F); if (DBL == 11) { __syncthreads(); ph_transposes(F); } __syncthreads(); ph_filter2(F); __syncthreads(); ph_h1(F); if (DBL == 13) ph_h1(F); SEAM(1); }
    if (IN(2)) {
        pg8::Gemm g{H1, (const bf16*)(F.ws + WS_WIN), MROWS, INW, DM}; pg8::StaticOrder S; S.init(MROWS, INW, (int)gridDim.x, (int)blockIdx.x);
        pg8::EpiStore E{PROJ, INW};
        pg8::gemm_phase<pg8::EpiStore, pg8::StaticOrder, true, true>(F.lds, g, S, E);
        if (DBL == 2) { __syncthreads(); pg8::gemm_phase<pg8::EpiStore, pg8::StaticOrder, true, true>(F.lds, g, S, E); }
        SEAM(2);
    }
    if (IN(3)) { ph_qkpost(F); ph_zprep(F); if (DBL == 32) { __syncthreads(); ph_zprep(F); } SEAM(3); }
    if (IN(4)) {
#if NAIVE_ATTN
        ph_attn_naive(F);
#else
        ph_attn_mfma(F);
        if (DBL == 41) { __syncthreads(); ph_attn_mfma(F); }
#endif
        __syncthreads();
#if NAIVE_HYENA
        ph_hyena_naive(F);
#else
        ph_hyena_mfma(F);
        if (DBL == 42) { __syncthreads(); ph_hyena_mfma(F); }
#endif
        SEAM(4); }
    if (IN(5)) { ph_merge(F); if (DBL == 5) { __syncthreads(); ph_merge(F); } SEAM(5); }
    if (IN(6)) {
        pg8::Gemm g{A2, (const bf16*)(F.ws + WS_WOUT), T, DM, DM}; pg8::StaticOrder S; S.init(T, DM, (int)gridDim.x, (int)blockIdx.x);
        pg8::EpiResid E{F.in[IN_X], F.out, (const float*)(F.ws + WS_MOD)};
        pg8::gemm_phase<pg8::EpiResid, pg8::StaticOrder, true, true>(F.lds, g, S, E);
        if (DBL == 6) { __syncthreads(); pg8::gemm_phase<pg8::EpiResid, pg8::StaticOrder, true, true>(F.lds, g, S, E); }
        SEAM(6);
    }
    if (IN(7)) { ph_h2(F); __syncthreads(); ph_router_mfma(F); SEAM(7); }
    if (IN(8)) { ph_gather(F); if (DBL == 8) { __syncthreads(); ph_gather(F); } SEAM(8); }
    if (IN(9)) {
        build_tile_table(F);
        pg8::Gemm g{XS, (const bf16*)(F.ws + WS_WGU), PMAX, 2048, DM};
        pg8::MoeOrder S{(const LAS int*)(F.lds + MISC_OFF), 8, (int)gridDim.x, (int)blockIdx.x, (size_t)2048 * 1024 * 2};
        pg8::EpiSwiglu E{HID, F.in[IN_BGU]};
        pg8::gemm_phase<pg8::EpiSwiglu, pg8::MoeOrder, true, true>(F.lds, g, S, E);
        if (DBL == 9) { __syncthreads(); pg8::gemm_phase<pg8::EpiSwiglu, pg8::MoeOrder, true, true>(F.lds, g, S, E); }
        SEAM(9);
    }
    if (IN(10)) {
        build_tile_table(F);
        pg8::Gemm g{HID, (const bf16*)(F.ws + WS_WD), PMAX, DM, DM};
        pg8::MoeOrder S{(const LAS int*)(F.lds + MISC_OFF), 4, (int)gridDim.x, (int)blockIdx.x, (size_t)1024 * 1024 * 2};
        pg8::EpiStoreBias E{XS, DM, F.in[IN_BDOWN], DM};
        pg8::gemm_phase<pg8::EpiStoreBias, pg8::MoeOrder, true, true>(F.lds, g, S, E);
        if (DBL == 10) { __syncthreads(); pg8::gemm_phase<pg8::EpiStoreBias, pg8::MoeOrder, true, true>(F.lds, g, S, E); }
        SEAM(10);
    }
    if (IN(11)) { ph_combine(F); }
#undef IN
#undef SEAM
}

extern "C" void kernel_launch(void* const* d_in, const int* in_sizes, int n_in, void* d_out, int out_size, void* d_ws, size_t ws_size, hipStream_t stream) {
    static int grid = 0;
    if (grid == 0) {
        if (n_in != 32 || out_size != T * DM || ws_size < WS_END) { fprintf(stderr, "kernel_launch: unexpected shapes n_in %d out %d ws %zu\n", n_in, out_size, ws_size); grid = -1; return; }
        int dev = 0, cus = 0, per_cu = 0;
        hipGetDevice(&dev); hipDeviceGetAttribute(&cus, hipDeviceAttributeMultiprocessorCount, dev);
        if (hipFuncSetAttribute((const void*)fwd, hipFuncAttributeMaxDynamicSharedMemorySize, LDS_BYTES) != hipSuccess) { fprintf(stderr, "kernel_launch: hipFuncSetAttribute failed\n"); grid = -1; return; }
        if (hipOccupancyMaxActiveBlocksPerMultiprocessor(&per_cu, (const void*)fwd, NTHR, LDS_BYTES) != hipSuccess || per_cu < 1) { fprintf(stderr, "kernel_launch: occupancy query says %d\n", per_cu); per_cu = 1; }
        (void)hipGetLastError();
        grid = cus * 1;
    }
    if (grid < 0) return;
    hipMemsetAsync((char*)d_ws + WS_CTL, 0, CTL_ZERO_BYTES, stream);
    Args a{};
    for (int i = 0; i < 32; ++i) a.in[i] = (const float*)d_in[i];
    a.out = (float*)d_out; a.ws = (unsigned char*)d_ws;
#if FUSED
    a.ph_lo = 0; a.ph_hi = NPHASES;
    void* kargs[] = {&a};
    hipError_t e = hipLaunchCooperativeKernel((const void*)fwd, dim3(grid), dim3(NTHR), kargs, LDS_BYTES, stream);
    if (e != hipSuccess) fprintf(stderr, "cooperative launch failed: %s (grid %d)\n", hipGetErrorString(e), grid);
#else
    for (int p = 0; p < NPHASES; ++p) { a.ph_lo = p; a.ph_hi = p + 1; hipLaunchKernelGGL(fwd, dim3(grid), dim3(NTHR), LDS_BYTES, stream, a); }
#endif
}
```
